# Optimizing an MI355X kernel written in HIP

```python
import jax, jax.numpy as jnp
from jax import lax
import numpy as np

D_MODEL = 1024
BATCH = 16
SEQ = 2048
DEPTH = 1
DEC_BATCH = 8
DEC_SEQ = 64
PAST_LEN = 4096

CHUNK = 64
QBLK = 128
SB_HEADS = 8
SB_HEAD_DIM = 128
SB_WIDTH = SB_HEADS * SB_HEAD_DIM
POOL_WINDOWS = (2, 4, 8, 16)
POOL_GROUPS = len(POOL_WINDOWS)
POOL_WIDTH = D_MODEL
POOL_GROUP_DIM = POOL_WIDTH // POOL_GROUPS
POOL_BUF = max(POOL_WINDOWS) - 1
IN_COLS = 4 * SB_WIDTH + 2 * POOL_WIDTH + 2 * D_MODEL
EPS = 1e-6

kernel_name = "stickbreak_pool_gated_hybrid_step"


def rmsnorm(x, g):
    xf = x.astype(jnp.float32)
    y = xf * lax.rsqrt(jnp.mean(xf * xf, axis=-1, keepdims=True) + EPS)
    return (y * g.astype(jnp.float32)).astype(x.dtype)


def split_proj(h, w_in):
    z = h @ w_in
    offs = np.cumsum([SB_WIDTH] * 4 + [POOL_WIDTH] * 2).tolist()
    q, k, v, ga, u, gb, mg = jnp.split(z, offs, axis=-1)
    b, t = h.shape[0], h.shape[1]
    hs = (b, t, SB_HEADS, SB_HEAD_DIM)
    return q.reshape(hs), k.reshape(hs), v.reshape(hs), ga, u, gb, mg


def stick_breaking(q, k, v, q_start):
    b, tq = q.shape[0], q.shape[1]
    tk = k.shape[1]
    z = jnp.einsum('bqhd,bkhd->bhqk', q, k,
                   preferred_element_type=jnp.float32) * (SB_HEAD_DIM ** -0.5)
    qpos = q_start + jnp.arange(tq)
    kpos = jnp.arange(tk)
    mask = kpos[None, :] < qpos[:, None]
    log_beta = jax.nn.log_sigmoid(z)
    log_1m = jnp.where(mask, log_beta - z, 0.0)
    after = lax.cumsum(log_1m, axis=3, reverse=True) - log_1m
    a = jnp.where(mask, jnp.exp(log_beta + after), 0.0)
    out = jnp.einsum('bhqk,bkhd->bqhd', a, v.astype(jnp.float32))
    return out.astype(q.dtype).reshape(b, tq, SB_WIDTH)


def multi_scale_pool(u, buf, pos_start, w_pool, pool_scale):
    b, t = u.shape[0], u.shape[1]
    ext = jnp.concatenate([buf.astype(u.dtype), u], axis=1).astype(jnp.float32)
    cs = jnp.cumsum(ext, axis=1)
    cs = jnp.concatenate([jnp.zeros_like(cs[:, :1]), cs], axis=1)
    pos = pos_start + jnp.arange(t)
    uf = u.astype(jnp.float32)
    outs = []
    for g, w in enumerate(POOL_WINDOWS):
        sl = slice(g * POOL_GROUP_DIM, (g + 1) * POOL_GROUP_DIM)
        hi = cs[:, POOL_BUF + 1:POOL_BUF + 1 + t, sl]
        lo = cs[:, POOL_BUF + 1 - w:POOL_BUF + 1 - w + t, sl]
        cnt = jnp.minimum(pos + 1, w).astype(jnp.float32)[None, :, None]
        outs.append((hi - lo) / cnt - uf[..., sl])
    p = jnp.concatenate(outs, axis=-1).astype(u.dtype)
    p = jnp.einsum('btgc,gcd->btgd', p.reshape(b, t, POOL_GROUPS, POOL_GROUP_DIM), w_pool)
    return p.reshape(b, t, POOL_WIDTH) * pool_scale


def merge_out(x, att, ga, pb, gb, mg, w_br_a, w_br_b, w_out):
    y_a = (att * jax.nn.silu(ga)) @ w_br_a
    y_b = (pb * jax.nn.silu(gb)) @ w_br_b
    gate = jax.nn.sigmoid(mg)
    m = gate[..., :D_MODEL] * y_a + gate[..., D_MODEL:] * y_b
    return x + m @ w_out


def setup_inputs(seed: int = 0) -> dict:
    key = jax.random.key(seed)
    ks = jax.random.split(key, 13)
    f = jnp.float32
    nrm = lambda k, s, sc: jax.random.normal(k, s, f) * sc
    return {
        "x_prompt": nrm(ks[0], (BATCH, SEQ, D_MODEL), 1.0),
        "x_sample": nrm(ks[1], (DEC_BATCH, DEC_SEQ, D_MODEL), 1.0),
        "cache_k": nrm(ks[2], (DEPTH, DEC_BATCH, PAST_LEN, SB_HEADS, SB_HEAD_DIM), 1.0),
        "cache_v": nrm(ks[3], (DEPTH, DEC_BATCH, PAST_LEN, SB_HEADS, SB_HEAD_DIM), 1.0),
        "state_pool": nrm(ks[4], (DEPTH, DEC_BATCH, POOL_BUF, POOL_WIDTH), 1.0),
        "norm_g": 1.0 + nrm(ks[5], (DEPTH, D_MODEL), 0.05),
        "w_in": nrm(ks[6], (DEPTH, D_MODEL, IN_COLS), D_MODEL ** -0.5),
        "w_pool": nrm(ks[7], (DEPTH, POOL_GROUPS, POOL_GROUP_DIM, POOL_GROUP_DIM), POOL_GROUP_DIM ** -0.5),
        "pool_scale": 1.0 + nrm(ks[8], (DEPTH, POOL_WIDTH), 0.1),
        "w_br_a": nrm(ks[9], (DEPTH, SB_WIDTH, D_MODEL), SB_WIDTH ** -0.5),
        "w_br_b": nrm(ks[10], (DEPTH, POOL_WIDTH, D_MODEL), POOL_WIDTH ** -0.5),
        "w_out": nrm(ks[11], (DEPTH, D_MODEL, D_MODEL), D_MODEL ** -0.5),
        "final_g": 1.0 + nrm(ks[12], (D_MODEL,), 0.05),
    }


def reference(x_prompt, x_sample, cache_k, cache_v, state_pool, norm_g, w_in, w_pool,
              pool_scale, w_br_a, w_br_b, w_out, final_g):
    xp, xs = x_prompt, x_sample
    past_len = cache_k.shape[2]
    kp_l, vp_l, pp_l, ks_l, vs_l, ps_l = [], [], [], [], [], []
    for l in range(DEPTH):
        h = rmsnorm(xp, norm_g[l])
        q, k, v, ga, u, gb, mg = split_proj(h, w_in[l])
        n_blk = xp.shape[1] // QBLK
        att = jnp.concatenate(
            [stick_breaking(q[:, i * QBLK:(i + 1) * QBLK], k[:, :(i + 1) * QBLK],
                            v[:, :(i + 1) * QBLK], i * QBLK) for i in range(n_blk)], axis=1)
        zero_buf = jnp.zeros((xp.shape[0], POOL_BUF, POOL_WIDTH), u.dtype)
        pb = multi_scale_pool(u, zero_buf, 0, w_pool[l], pool_scale[l])
        xp = merge_out(xp, att, ga, pb, gb, mg, w_br_a[l], w_br_b[l], w_out[l])
        kp_l.append(k)
        vp_l.append(v)
        pp_l.append(u[:, -POOL_BUF:])

        h = rmsnorm(xs, norm_g[l])
        q, k, v, ga, u, gb, mg = split_proj(h, w_in[l])
        k_all = jnp.concatenate([cache_k[l].astype(k.dtype), k], axis=1)
        v_all = jnp.concatenate([cache_v[l].astype(v.dtype), v], axis=1)
        att = stick_breaking(q, k_all, v_all, past_len)
        buf = state_pool[l].astype(u.dtype)
        pb = multi_scale_pool(u, buf, past_len, w_pool[l], pool_scale[l])
        xs = merge_out(xs, att, ga, pb, gb, mg, w_br_a[l], w_br_b[l], w_out[l])
        ks_l.append(k)
        vs_l.append(v)
        ps_l.append(jnp.concatenate([buf, u], axis=1)[:, -POOL_BUF:])

    y_prompt = rmsnorm(xp, final_g)
    y_sample = rmsnorm(xs, final_g)
    return (y_prompt, y_sample, jnp.stack(kp_l), jnp.stack(vp_l), jnp.stack(pp_l),
            jnp.stack(ks_l), jnp.stack(vs_l), jnp.stack(ps_l))
```

```cpp
#include <hip/hip_runtime.h>
#include <hip/hip_cooperative_groups.h>
#include <cstdio>
#include <cstdint>
namespace cg = cooperative_groups;

constexpr int D = 1024, NB = 16, T = 2048, SB = 8, TS = 64, PAST = 4096, NH = 8, HD = 128;
constexpr int MP = NB * T, MS = SB * TS, MT = MP + MS;
constexpr int NIN = 8192;
constexpr int PBUF = 15;
constexpr float EPS = 1e-6f;
constexpr float QSCALE = 0.12751743082459868f;
constexpr size_t OFF_Y = 0, OFF_KP = (size_t)MT * D, OFF_VP = OFF_KP + (size_t)MP * D, OFF_PP = OFF_VP + (size_t)MP * D,
                 OFF_KS = OFF_PP + (size_t)NB * PBUF * D, OFF_VS = OFF_KS + (size_t)MS * D, OFF_PS = OFF_VS + (size_t)MS * D;
constexpr size_t MiB = 1u << 20, RB = (size_t)MT * D * 2;
constexpr size_t WS_ROWSS = 0, WS_BAR = 512 * 1024, WS_CNT = WS_BAR + 16384, WS_BAR_BYTES = 16384 + 1024, WS_WIN = 1 * MiB, WS_WPOOL = 17 * MiB, WS_WBRA = 18 * MiB, WS_WBRB = 20 * MiB, WS_WOUT = 22 * MiB;
constexpr size_t WS_Q = 24 * MiB, WS_GA = WS_Q + RB, WS_U = WS_GA + RB, WS_GB = WS_U + RB, WS_H = WS_GB + RB, WS_MG = WS_H + RB, WS_END = WS_MG + 2 * RB;

#define LAS __attribute__((address_space(3)))
typedef unsigned short bf16_t;
typedef short bf16x8 __attribute__((ext_vector_type(8)));
typedef short s16x4 __attribute__((ext_vector_type(4)));
typedef float f32x4 __attribute__((ext_vector_type(4)));
typedef float f32x8 __attribute__((ext_vector_type(8)));
typedef float f32x16 __attribute__((ext_vector_type(16)));
typedef unsigned u32x4 __attribute__((ext_vector_type(4)));
typedef unsigned u32x2 __attribute__((ext_vector_type(2)));

typedef float f32x2_t __attribute__((ext_vector_type(2)));
typedef __bf16 bf16x2_t __attribute__((ext_vector_type(2)));
__device__ __forceinline__ unsigned cvt_pk_bf16(float lo, float hi) { const f32x2_t v = {lo, hi}; const bf16x2_t b = __builtin_convertvector(v, bf16x2_t); return __builtin_bit_cast(unsigned, b); }
__device__ __forceinline__ float bf_lo(unsigned w) { return __uint_as_float(w << 16); }
__device__ __forceinline__ float bf_hi(unsigned w) { return __uint_as_float(w & 0xffff0000u); }
__device__ __forceinline__ float sigmoidf_(float v) { return __builtin_amdgcn_rcpf(1.0f + __builtin_amdgcn_exp2f(-1.4426950408889634f * v)); }
__device__ __forceinline__ float wave_sum(float v) {
#pragma unroll
    for (int o = 1; o < 64; o <<= 1) v += __shfl_xor(v, o);
    return v;
}

namespace pg8 {
constexpr int BM = 256, BK = 64, HALF = 128, HTB = HALF * BK * 2, STAGE_BYTES = 8 * HTB, NXCD = 8, WGM = 8;
__device__ __forceinline__ int lds_byte(int r, int c) { const int st = (r >> 4) * 2 + (c >> 5), rr = r & 15, cc = c & 31, ob = rr * 64 + cc * 2; return st * 1024 + (ob ^ (((ob >> 9) & 1) << 5)); }
__device__ __forceinline__ void stage_rc(int b, int& R, int& C) { const int st = b / 1024, sb = b % 1024, swz = sb ^ (((sb >> 9) & 1) << 5); R = (st >> 1) * 16 + swz / 64; C = (st & 1) * 32 + (swz % 64) / 2; }
__device__ __forceinline__ int perm32(int rho) { const int n = rho >> 4, i = rho & 15; return 8 * (i >> 2) + 4 * n + (i & 3); }

struct Unit { int pm, pn, br; };
struct Sched {
    int nM, nN, nwg, G, c, dual;
    const char *A0, *A1, *B0, *B1; size_t a_pm, a_pn, b_pn;
    __device__ __forceinline__ bool next(int i, Unit& u) const {
        const int rnd = dual ? (i >> 1) : i;
        const long L = (long)rnd * G + c; if (L >= nwg) return false;
        int wgid = (int)L; { const int q = nwg / NXCD, r = nwg % NXCD, xcd = wgid % NXCD, off = wgid / NXCD; wgid = (xcd < r ? xcd * (q + 1) : r * (q + 1) + (xcd - r) * q) + off; }
        const int nig = WGM * nN, gid = wgid / nig, fm = gid * WGM, gsz = (nM - fm) < WGM ? (nM - fm) : WGM;
        u.pm = fm + ((wgid % nig) % gsz); u.pn = (wgid % nig) / gsz; u.br = dual ? (i & 1) : 0; return true;
    }
    __device__ __forceinline__ const char* abase(const Unit& u) const { return (u.br ? A1 : A0) + (size_t)u.pm * a_pm + (size_t)u.pn * a_pn; }
    __device__ __forceinline__ const char* bbase(const Unit& u) const { return (u.br ? B1 : B0) + (size_t)u.pn * b_pn; }
};

template <class Epi>
__device__ __forceinline__ void gemm_phase(LAS unsigned char* lds, const int lda, const int ldb, const int K, const Sched& S, const Epi& E) {
    const int tid = threadIdx.x, wid = __builtin_amdgcn_readfirstlane(tid >> 6), lane = tid & 63, wr = wid >> 2, wc = wid & 3, fr = lane & 15, fq = lane >> 4;
    const int nt = K / BK;
    unsigned voffA[2], voffB[2];
#pragma unroll
    for (int i = 0; i < 2; ++i) { int R, C; stage_rc(tid * 16 + i * 8192, R, C); const int Rb = (R & ~31) + perm32(R & 31);
        voffA[i] = (unsigned)(R * lda + C) * 2u; voffB[i] = (unsigned)(Rb * ldb + C) * 2u; }
    const size_t kstep = (size_t)(BK * 2);
    const size_t hstepA = (size_t)HALF * lda * 2, hstepB = (size_t)HALF * ldb * 2;
    const unsigned ldsw = (unsigned)wid * 1024u;
    const int aoff = lds_byte(wr * 64 + fr, fq * 8), boff = lds_byte(wc * 32 + fr, fq * 8);
#define PG8_SA(b, h) (((b) * 2 + (h)) * HTB)
#define PG8_SB(b, h) ((4 + (b) * 2 + (h)) * HTB)
#define PG8_STAGE(bufoff, gbase, voff) do { _Pragma("unroll") for (int _i = 0; _i < 2; ++_i) \
        __builtin_amdgcn_global_load_lds((const unsigned*)((const char*)(gbase) + (voff)[_i]), (LAS unsigned*)(lds + (bufoff) + ldsw + _i * 8192), 16, 0, 0); } while (0)
#define PG8_LDA(dst, b, h) do { _Pragma("unroll") for (int m = 0; m < 4; ++m) _Pragma("unroll") for (int k = 0; k < 2; ++k) dst[m][k] = *(const LAS bf16x8*)(lds + PG8_SA(b, h) + aoff + m * 2048 + k * 1024); } while (0)
#define PG8_LDB(dst, b, h) do { _Pragma("unroll") for (int n = 0; n < 2; ++n) _Pragma("unroll") for (int k = 0; k < 2; ++k) dst[n][k] = *(const LAS bf16x8*)(lds + PG8_SB(b, h) + boff + n * 2048 + k * 1024); } while (0)
#define PG8_MMA(ai, bj, At, Bt) do { __builtin_amdgcn_s_setprio(1); _Pragma("unroll") for (int m = 0; m < 4; ++m) _Pragma("unroll") for (int n = 0; n < 2; ++n) _Pragma("unroll") for (int k = 0; k < 2; ++k) \
        acc[ai][bj][m][n] = __builtin_amdgcn_mfma_f32_16x16x32_bf16(Bt[n][k], At[m][k], acc[ai][bj][m][n], 0, 0, 0); __builtin_amdgcn_s_setprio(0); } while (0)
#define PG8_WAIT_V(n) asm volatile("s_waitcnt vmcnt(" #n ")" ::: "memory")
#define PG8_WAIT_L(n) asm volatile("s_waitcnt lgkmcnt(" #n ")" ::: "memory")
#define PG8_BAR __builtin_amdgcn_s_barrier()
#define PG8_SCHED __builtin_amdgcn_sched_barrier(0)
    Unit cur, nxt; int ui = 0;
    if (!S.next(0, cur)) return;
    f32x4 acc[2][2][4][2];
#pragma unroll
    for (int a = 0; a < 2; ++a)
#pragma unroll
        for (int b = 0; b < 2; ++b)
#pragma unroll
            for (int m = 0; m < 4; ++m)
#pragma unroll
                for (int n = 0; n < 2; ++n) acc[a][b][m][n] = (f32x4){0.f, 0.f, 0.f, 0.f};
    bf16x8 At[4][2], B0[2][2], B1[2][2];
    const char* cA = S.abase(cur); const char* cB = S.bbase(cur);
    PG8_STAGE(PG8_SB(0, 0), cB, voffB); PG8_STAGE(PG8_SB(0, 1), cB + hstepB, voffB); PG8_STAGE(PG8_SA(0, 0), cA, voffA); PG8_STAGE(PG8_SA(0, 1), cA + hstepA, voffA);
    if (wr == 1) PG8_BAR;
    PG8_WAIT_V(2); PG8_BAR;
    PG8_STAGE(PG8_SB(1, 0), cB + kstep, voffB); PG8_STAGE(PG8_SA(1, 0), cA + kstep, voffA); PG8_STAGE(PG8_SB(1, 1), cB + hstepB + kstep, voffB);
    PG8_WAIT_V(6); PG8_BAR;
    for (;;) {
        const bool has_next = S.next(ui + 1, nxt);
        const char* nA = has_next ? S.abase(nxt) : cA; const char* nB = has_next ? S.bbase(nxt) : cB;
#pragma unroll 1
        for (int t = 0; t < nt; t += 2) {
            const bool last = (t == nt - 2);
            const char* a1 = cA + (size_t)(t + 1) * kstep;
            const char* a2 = last ? nA : cA + (size_t)(t + 2) * kstep; const char* b2 = last ? nB : cB + (size_t)(t + 2) * kstep;
            const char* a3 = a2 + kstep; const char* b3 = b2 + kstep;
            PG8_LDB(B0, 0, 0); PG8_LDB(B1, 0, 1); PG8_SCHED; PG8_LDA(At, 0, 0); PG8_STAGE(PG8_SA(1, 1), a1 + hstepA, voffA);
            PG8_WAIT_V(8); PG8_WAIT_L(0); PG8_BAR; PG8_MMA(0, 0, At, B0); PG8_MMA(0, 1, At, B1); PG8_BAR; PG8_SCHED;
            PG8_LDA(At, 0, 1); PG8_STAGE(PG8_SB(0, 0), b2, voffB); PG8_STAGE(PG8_SB(0, 1), b2 + hstepB, voffB); PG8_STAGE(PG8_SA(0, 0), a2, voffA);
            PG8_WAIT_V(8); PG8_WAIT_L(0); PG8_BAR; PG8_MMA(1, 0, At, B0); PG8_MMA(1, 1, At, B1); PG8_BAR; PG8_SCHED;
            PG8_LDB(B0, 1, 0); PG8_LDB(B1, 1, 1); PG8_SCHED; PG8_LDA(At, 1, 0); PG8_STAGE(PG8_SA(0, 1), a2 + hstepA, voffA);
            PG8_WAIT_V(8); PG8_WAIT_L(0); PG8_BAR; PG8_MMA(0, 0, At, B0); PG8_MMA(0, 1, At, B1); PG8_BAR; PG8_SCHED;
            PG8_LDA(At, 1, 1); PG8_STAGE(PG8_SB(1, 0), b3, voffB); PG8_STAGE(PG8_SB(1, 1), b3 + hstepB, voffB); PG8_STAGE(PG8_SA(1, 0), a3, voffA);
            PG8_WAIT_V(8); PG8_WAIT_L(0); PG8_BAR; PG8_MMA(1, 0, At, B0); PG8_MMA(1, 1, At, B1); PG8_BAR; PG8_SCHED;
        }
        if (wr == 0) PG8_BAR;
        const bool keep = E(acc, cur, wr, wc, fr, fq);
        if (!has_next) break;
        if (!keep) {
#pragma unroll
        for (int a = 0; a < 2; ++a)
#pragma unroll
            for (int b = 0; b < 2; ++b)
#pragma unroll
                for (int m = 0; m < 4; ++m)
#pragma unroll
                    for (int n = 0; n < 2; ++n) acc[a][b][m][n] = (f32x4){0.f, 0.f, 0.f, 0.f};
        }
        cur = nxt; cA = nA; cB = nB; ++ui;
        if (wr == 1) PG8_BAR;
    }
    PG8_WAIT_V(0);
    PG8_BAR;
#undef PG8_SA
#undef PG8_SB
#undef PG8_STAGE
#undef PG8_LDA
#undef PG8_LDB
#undef PG8_MMA
#undef PG8_WAIT_V
#undef PG8_WAIT_L
#undef PG8_BAR
#undef PG8_SCHED
}
}

typedef f32x4 AccT[2][2][4][2];
#define EPI_ROWS(u) const int row0 = (u).pm * 256 + wr * 64 + fr
#define EPI_FOR_AI_M _Pragma("unroll") for (int ai = 0; ai < 2; ++ai) _Pragma("unroll") for (int m = 0; m < 4; ++m)

__device__ __forceinline__ u32x4 pack8(const f32x4 v0, const f32x4 v1) {
    u32x4 w; w.x = cvt_pk_bf16(v0[0], v0[1]); w.y = cvt_pk_bf16(v0[2], v0[3]); w.z = cvt_pk_bf16(v1[0], v1[1]); w.w = cvt_pk_bf16(v1[2], v1[3]); return w;
}
template <int ACT> __device__ __forceinline__ f32x4 act4(f32x4 v) {
    f32x4 o;
#pragma unroll
    for (int j = 0; j < 4; ++j) { const float x = v[j]; o[j] = ACT == 0 ? x * QSCALE : ACT == 1 ? x * sigmoidf_(x) : ACT == 2 ? sigmoidf_(x) : x; }
    return o;
}
template <int ACT> __device__ __forceinline__ void store_bf16_tile(const AccT& acc, bf16_t* base, int ld, int row0, int col0) {
    EPI_FOR_AI_M { bf16_t* rowp = base + (size_t)(row0 + ai * 128 + m * 16) * ld + col0;
#pragma unroll
        for (int bj = 0; bj < 2; ++bj) *(u32x4*)(rowp + bj * 128) = pack8(act4<ACT>(acc[ai][bj][m][0]), act4<ACT>(acc[ai][bj][m][1])); }
}
struct EpiIn {
    bf16_t *Q, *GA, *U, *GB, *MG; float* out;
    __device__ __forceinline__ bool operator()(AccT& acc, const pg8::Unit& u, int wr, int wc, int fr, int fq) const {
        EPI_ROWS(u);
        const int sec = u.pn >> 2, col0 = (u.pn & 3) * 256 + wc * 32 + 8 * fq;
        if (sec == 0) store_bf16_tile<0>(acc, Q, D, row0, col0);
        else if (sec == 3) store_bf16_tile<1>(acc, GA, D, row0, col0);
        else if (sec == 5) store_bf16_tile<1>(acc, GB, D, row0, col0);
        else if (sec >= 6) store_bf16_tile<2>(acc, MG, 2 * D, row0, (sec - 6) * D + col0);
        else if (sec == 4) {
            store_bf16_tile<3>(acc, U, D, row0, col0);
            const bool samp = u.pm >= MP / 256;
            if (samp || (u.pm & 7) == 7) {
                EPI_FOR_AI_M { const int row = row0 + ai * 128 + m * 16; int b, tt; float* pb;
                    if (samp) { b = (row - MP) >> 6; tt = ((row - MP) & 63) - (TS - PBUF); pb = out + OFF_PS; } else { b = row >> 11; tt = (row & 2047) - (T - PBUF); pb = out + OFF_PP; }
                    if (tt >= 0) { float* rp = pb + ((size_t)b * PBUF + tt) * D + col0;
#pragma unroll
                        for (int bj = 0; bj < 2; ++bj) { *(f32x4*)(rp + bj * 128) = acc[ai][bj][m][0]; *(f32x4*)(rp + bj * 128 + 4) = acc[ai][bj][m][1]; } } }
            }
        } else {
            const bool samp = u.pm >= MP / 256;
            float* base = out + (sec == 1 ? (samp ? OFF_KS : OFF_KP) : (samp ? OFF_VS : OFF_VP));
            const int r0 = samp ? row0 - MP : row0;
            EPI_FOR_AI_M { float* rp = base + (size_t)(r0 + ai * 128 + m * 16) * D + col0;
#pragma unroll
                for (int bj = 0; bj < 2; ++bj) { *(f32x4*)(rp + bj * 128) = acc[ai][bj][m][0]; *(f32x4*)(rp + bj * 128 + 4) = acc[ai][bj][m][1]; } }
            if (!samp) {
                bf16_t* kvb = (bf16_t*)(out + OFF_Y) + (sec == 1 ? (size_t)0 : (size_t)MP * D);
                store_bf16_tile<3>(acc, kvb, D, row0, col0);
            }
        }
        return false;
    }
};
struct EpiPool {
    bf16_t* GB; const float* scale;
    __device__ __forceinline__ bool operator()(AccT& acc, const pg8::Unit& u, int wr, int wc, int fr, int fq) const {
        EPI_ROWS(u); const int col0 = u.pn * 256 + wc * 32 + 8 * fq;
        EPI_FOR_AI_M { bf16_t* rowp = GB + (size_t)(row0 + ai * 128 + m * 16) * D + col0;
#pragma unroll
            for (int bj = 0; bj < 2; ++bj) { const u32x4 g = *(const u32x4*)(rowp + bj * 128);
                f32x4 v0 = acc[ai][bj][m][0] * *(const f32x4*)(scale + col0 + bj * 128), v1 = acc[ai][bj][m][1] * *(const f32x4*)(scale + col0 + bj * 128 + 4);
                v0 = v0 * (f32x4){bf_lo(g.x), bf_hi(g.x), bf_lo(g.y), bf_hi(g.y)}; v1 = v1 * (f32x4){bf_lo(g.z), bf_hi(g.z), bf_lo(g.w), bf_hi(g.w)};
                *(u32x4*)(rowp + bj * 128) = pack8(v0, v1); } }
        return false;
    }
};
struct EpiBr {
    bf16_t* M; const bf16_t* MG;
    __device__ __forceinline__ bool operator()(AccT& acc, const pg8::Unit& u, int wr, int wc, int fr, int fq) const {
        EPI_ROWS(u); const int col0 = u.pn * 256 + wc * 32 + 8 * fq;
        if (u.br == 0) {
            EPI_FOR_AI_M { const size_t row = (size_t)(row0 + ai * 128 + m * 16); const bf16_t* gp = MG + row * (2 * D) + col0;
#pragma unroll
                for (int bj = 0; bj < 2; ++bj) { const u32x4 ga = *(const u32x4*)(gp + bj * 128), gb = *(const u32x4*)(gp + D + bj * 128);
                    const f32x4 a0 = {bf_lo(ga.x), bf_hi(ga.x), bf_lo(ga.y), bf_hi(ga.y)}, a1 = {bf_lo(ga.z), bf_hi(ga.z), bf_lo(ga.w), bf_hi(ga.w)};
                    const f32x4 b0 = {bf_lo(gb.x), bf_hi(gb.x), bf_lo(gb.y), bf_hi(gb.y)}, b1 = {bf_lo(gb.z), bf_hi(gb.z), bf_lo(gb.w), bf_hi(gb.w)};
#pragma unroll
                    for (int j = 0; j < 4; ++j) { acc[ai][bj][m][0][j] *= a0[j] * __builtin_amdgcn_rcpf(fmaxf(b0[j], 1e-35f)); acc[ai][bj][m][1][j] *= a1[j] * __builtin_amdgcn_rcpf(fmaxf(b1[j], 1e-35f)); } } }
            return true;
        }
        EPI_FOR_AI_M { const size_t row = (size_t)(row0 + ai * 128 + m * 16); bf16_t* rowp = M + row * D + col0; const bf16_t* gp = MG + row * (2 * D) + D + col0;
#pragma unroll
            for (int bj = 0; bj < 2; ++bj) { const u32x4 g = *(const u32x4*)(gp + bj * 128);
                const f32x4 v0 = acc[ai][bj][m][0] * (f32x4){bf_lo(g.x), bf_hi(g.x), bf_lo(g.y), bf_hi(g.y)}, v1 = acc[ai][bj][m][1] * (f32x4){bf_lo(g.z), bf_hi(g.z), bf_lo(g.w), bf_hi(g.w)};
                *(u32x4*)(rowp + bj * 128) = pack8(v0, v1); } }
        return false;
    }
};
struct EpiOut {
    const float* xp; float* y; float* rowss; unsigned* cnt; const float* fg;
    __device__ __forceinline__ bool operator()(AccT& acc, const pg8::Unit& u, int wr, int wc, int fr, int fq) const {
        EPI_ROWS(u); const int col0 = u.pn * 256 + wc * 32 + 8 * fq;
        EPI_FOR_AI_M { const size_t row = (size_t)(row0 + ai * 128 + m * 16); const float* xr = xp + row * D + col0; float ss = 0.f;
#pragma unroll
            for (int bj = 0; bj < 2; ++bj) { const f32x4 a = *(const f32x4*)(xr + bj * 128) + acc[ai][bj][m][0], b = *(const f32x4*)(xr + bj * 128 + 4) + acc[ai][bj][m][1];
                acc[ai][bj][m][0] = a; acc[ai][bj][m][1] = b;
                ss += (a[0] * a[0] + a[1] * a[1]) + (a[2] * a[2] + a[3] * a[3]) + (b[0] * b[0] + b[1] * b[1]) + (b[2] * b[2] + b[3] * b[3]); }
            ss += __shfl_xor(ss, 16); ss += __shfl_xor(ss, 32);
            if (fq == 0) atomicAdd(rowss + row, ss); }
        asm volatile("s_waitcnt vmcnt(0)" ::: "memory");
        __builtin_amdgcn_s_barrier(); asm volatile("" ::: "memory");
        if (threadIdx.x == 0) {
            __hip_atomic_fetch_add(cnt + u.pm, 1u, __ATOMIC_RELAXED, __HIP_MEMORY_SCOPE_AGENT);
            unsigned sp = 0;
            while (__hip_atomic_load(cnt + u.pm, __ATOMIC_RELAXED, __HIP_MEMORY_SCOPE_AGENT) < 4u) { __builtin_amdgcn_s_sleep(1); if (++sp > (1u << 22)) break; }
            __builtin_amdgcn_fence(__ATOMIC_ACQUIRE, "agent");
            asm volatile("s_waitcnt vmcnt(0)" ::: "memory");
        }
        __builtin_amdgcn_s_barrier(); asm volatile("" ::: "memory");
        EPI_FOR_AI_M { const size_t row = (size_t)(row0 + ai * 128 + m * 16); float* yr = y + row * D + col0;
            const float rstd = 1.0f / sqrtf(__hip_atomic_load(rowss + row, __ATOMIC_RELAXED, __HIP_MEMORY_SCOPE_AGENT) * (1.f / D) + EPS);
#pragma unroll
            for (int bj = 0; bj < 2; ++bj) { const f32x4 g0 = *(const f32x4*)(fg + col0 + bj * 128), g1 = *(const f32x4*)(fg + col0 + bj * 128 + 4);
                *(f32x4*)(yr + bj * 128) = acc[ai][bj][m][0] * rstd * g0; *(f32x4*)(yr + bj * 128 + 4) = acc[ai][bj][m][1] * rstd * g1; } }
        return false;
    }
};

namespace att {
constexpr int SHM_K = 16384, SHM_V = 16384, FLAG_OFF = 65536;
#define KSWZ(row, colB) ((row) * 256 + ((colB) ^ (((row) & 7) << 4)))
#define SBAR() __builtin_amdgcn_sched_barrier(0)
__device__ __forceinline__ int crow(int r, int hi) { return (r & 3) + 8 * (r >> 2) + 4 * hi; }
__device__ __forceinline__ bf16x8 tobf(f32x8 x) { u32x4 w = {cvt_pk_bf16(x[0], x[1]), cvt_pk_bf16(x[2], x[3]), cvt_pk_bf16(x[4], x[5]), cvt_pk_bf16(x[6], x[7])}; return __builtin_bit_cast(bf16x8, w); }
__device__ __forceinline__ void qkt(f32x16& p0, f32x16& p1, const char* Ks, const bf16x8* qr, int r32, int hi) {
    p0 = f32x16{}; p1 = f32x16{};
#pragma unroll
    for (int d0 = 0; d0 < 8; ++d0) { const int cb = (d0 * 16 + hi * 8) * 2;
        const bf16x8 b0 = *reinterpret_cast<const bf16x8*>(Ks + KSWZ(r32, cb));
        const bf16x8 b1 = *reinterpret_cast<const bf16x8*>(Ks + KSWZ(32 + r32, cb));
        p0 = __builtin_amdgcn_mfma_f32_32x32x16_bf16(b0, qr[d0], p0, 0, 0, 0);
        p1 = __builtin_amdgcn_mfma_f32_32x32x16_bf16(b1, qr[d0], p1, 0, 0, 0); }
}
__device__ __forceinline__ int v_st(int k, int c) { const int kk = (k & ~0xC) | ((k & 4) << 1) | ((k & 8) >> 1); return ((kk >> 3) * 4 + (c >> 5)) * 512 + ((kk & 7) * 32 + (c & 31)) * 2; }
__device__ __forceinline__ int v_rd_base(int lane) { return ((lane & 3) << 3) | (((lane >> 2) & 3) << 6) | (((lane >> 4) & 1) << 5) | (((lane >> 5) & 1) << 8); }
constexpr int v_rd_off(int d0, int ks, int half) { return d0 * 512 + ks * 4096 + half * 2048; }
template <int OFF> __device__ __forceinline__ s16x4 tr_read(int vb) { s16x4 r; asm volatile("ds_read_b64_tr_b16 %0, %1 offset:%2" : "=&v"(r) : "v"(vb), "i"(OFF) : "memory"); return r; }
template <int D0> __device__ __forceinline__ void pv_one(f32x16& od, int vb, bf16x8 pa0, bf16x8 pa1, bf16x8 pa2, bf16x8 pa3) {
    const s16x4 l0 = tr_read<v_rd_off(D0, 0, 0)>(vb), h0 = tr_read<v_rd_off(D0, 0, 1)>(vb), l1 = tr_read<v_rd_off(D0, 1, 0)>(vb), h1 = tr_read<v_rd_off(D0, 1, 1)>(vb);
    const s16x4 l2 = tr_read<v_rd_off(D0, 2, 0)>(vb), h2 = tr_read<v_rd_off(D0, 2, 1)>(vb), l3 = tr_read<v_rd_off(D0, 3, 0)>(vb), h3 = tr_read<v_rd_off(D0, 3, 1)>(vb);
    asm volatile("s_waitcnt lgkmcnt(0)" ::: "memory"); SBAR();
#define PK(L, H) (bf16x8){L[0], L[1], L[2], L[3], H[0], H[1], H[2], H[3]}
    od = __builtin_amdgcn_mfma_f32_32x32x16_bf16(pa0, PK(l0, h0), od, 0, 0, 0);
    od = __builtin_amdgcn_mfma_f32_32x32x16_bf16(pa1, PK(l1, h1), od, 0, 0, 0);
    od = __builtin_amdgcn_mfma_f32_32x32x16_bf16(pa2, PK(l2, h2), od, 0, 0, 0);
    od = __builtin_amdgcn_mfma_f32_32x32x16_bf16(pa3, PK(l3, h3), od, 0, 0, 0);
#undef PK
}
__device__ __forceinline__ float partner(float x, int hi) {
    auto rr = __builtin_amdgcn_permlane32_swap(__float_as_uint(x), __float_as_uint(x), false, false);
    return __uint_as_float(hi ? rr[0] : rr[1]);
}
template <bool MASK> __device__ __forceinline__ void sb_block(f32x16& p, float* tl, int keybase, int qpos, int hi) {
#pragma unroll
    for (int m = 0; m < 4; ++m) {
        float b[4], c[4];
#pragma unroll
        for (int i = 0; i < 4; ++i) {
            const float e = __builtin_amdgcn_exp2f(-__builtin_fmaxf(p[4 * m + i], -126.f)), r = __builtin_amdgcn_rcpf(1.0f + e);
            b[i] = r; c[i] = e * r;
            if (MASK) { const bool masked = (keybase + 8 * m + 4 * hi + i) >= qpos; b[i] = masked ? 0.f : b[i]; c[i] = masked ? 1.f : c[i]; }
        }
        const float x2 = c[3], x1 = c[3] * c[2], x0 = x1 * c[1];
        p[4 * m + 3] = b[3]; p[4 * m + 2] = b[2] * x2; p[4 * m + 1] = b[1] * x1; p[4 * m + 0] = b[0] * x0;
        tl[m] = x0 * c[0];
    }
}

struct AttUnit { bf16_t* Q; const bf16_t* G; const float *Kc, *Vc, *Kn, *Vn; const bf16_t *Kb, *Vb; int ncache_tiles, qpos0, nq; };

__device__ __forceinline__ void tile_compute(f32x16 (&o)[4], float& carry, bool& wdone, const bf16x8 (&qr)[8], const char* Kt, int vb, int jt, int qpos, int qmin, int r32, int hi) {
    f32x16 p0, p1;
    qkt(p0, p1, Kt, qr, r32, hi);
    const bool need_mask = (64 * jt + 63) >= qmin;
    float tl[8];
    if (need_mask) { sb_block<true>(p0, tl, 64 * jt, qpos, hi); sb_block<true>(p1, tl + 4, 64 * jt + 32, qpos, hi); }
    else { sb_block<false>(p0, tl, 64 * jt, qpos, hi); sb_block<false>(p1, tl + 4, 64 * jt + 32, qpos, hi); }
    float Sl[9]; Sl[8] = 1.f;
#pragma unroll
    for (int m = 7; m >= 0; --m) Sl[m] = Sl[m + 1] * tl[m];
#pragma unroll
    for (int m = 0; m < 8; ++m) {
        auto rr = __builtin_amdgcn_permlane32_swap(__float_as_uint(Sl[m]), __float_as_uint(Sl[m + 1]), false, false);
        const float sp = __uint_as_float(hi ? rr[0] : rr[1]);
        const float W = carry * (Sl[m + 1] * sp);
        if (m < 4) {
#pragma unroll
            for (int i = 0; i < 4; ++i) p0[4 * m + i] *= W;
        } else {
#pragma unroll
            for (int i = 0; i < 4; ++i) p1[4 * (m - 4) + i] *= W;
        }
    }
    carry *= Sl[0] * partner(Sl[0], hi);
    bf16x8 pa0, pa1, pa2, pa3;
#define PK4(P, BASE, OUT) do { unsigned a0 = cvt_pk_bf16(P[BASE + 0], P[BASE + 1]), a1 = cvt_pk_bf16(P[BASE + 2], P[BASE + 3]);   \
    unsigned b0 = cvt_pk_bf16(P[BASE + 4], P[BASE + 5]), b1 = cvt_pk_bf16(P[BASE + 6], P[BASE + 7]);                              \
    auto r0 = __builtin_amdgcn_permlane32_swap(a0, b0, false, false); auto r1 = __builtin_amdgcn_permlane32_swap(a1, b1, false, false); \
    u32x4 w = {r0[0], r1[0], r0[1], r1[1]}; OUT = __builtin_bit_cast(bf16x8, w); } while (0)
    PK4(p0, 0, pa0); PK4(p0, 8, pa1); PK4(p1, 0, pa2); PK4(p1, 8, pa3);
#undef PK4
    pv_one<0>(o[0], vb, pa0, pa1, pa2, pa3); pv_one<1>(o[1], vb, pa0, pa1, pa2, pa3); pv_one<2>(o[2], vb, pa0, pa1, pa2, pa3); pv_one<3>(o[3], vb, pa0, pa1, pa2, pa3);
    if (__all(carry < 1.17549435e-38f)) wdone = true;
}
__device__ __forceinline__ void attn_store_p(const bf16_t* __restrict__ gp, bf16_t* __restrict__ qp, const f32x16 (&o)[4], int wid, int r32, int hi) {
#pragma unroll
    for (int dh = 0; dh < 2; ++dh) {
        unsigned short g[2][16];
#pragma unroll
        for (int d1 = 0; d1 < 2; ++d1)
#pragma unroll
            for (int r = 0; r < 16; ++r) g[d1][r] = gp[(size_t)(wid * 32 + crow(r, hi)) * D + r32 + (2 * dh + d1) * 32];
#pragma unroll
        for (int d1 = 0; d1 < 2; ++d1)
#pragma unroll
            for (int r = 0; r < 16; ++r) { const float gv = __uint_as_float((unsigned)g[d1][r] << 16);
                qp[(size_t)(wid * 32 + crow(r, hi)) * D + r32 + (2 * dh + d1) * 32] = (bf16_t)(cvt_pk_bf16(o[2 * dh + d1][r] * gv, 0.f) & 0xffffu); }
    }
}
__device__ __forceinline__ void attn_store(const AttUnit& U, const f32x16 (&o)[4], int wid, int r32, int hi) { attn_store_p(U.G, U.Q, o, wid, r32, hi); }
#define ATT_COMMON() \
    const int tid = threadIdx.x, wid = __builtin_amdgcn_readfirstlane(tid >> 6), lane = tid & 63, r32 = lane & 31, hi = lane >> 5; \
    char* V_lds = lds; char* K_lds = lds + 2 * SHM_V; volatile LAS int* fl = (volatile LAS int*)((LAS char*)lds + FLAG_OFF); \
    const bool wactive = wid * 32 < U.nq; \
    bf16x8 qr[8]; \
    { const bf16_t* Qw = U.Q + (size_t)(wactive ? wid * 32 + r32 : r32) * D + hi * 8; \
      _Pragma("unroll") for (int d0 = 0; d0 < 8; ++d0) qr[d0] = *reinterpret_cast<const bf16x8*>(Qw + d0 * 16); } \
    f32x16 o[4] = {}; float carry = 1.f; \
    const int qpos = U.qpos0 + wid * 32 + r32, qmin = U.qpos0 + wid * 32; \
    const int whi = (U.qpos0 + wid * 32 + 30) >> 6, T0 = (U.qpos0 + U.nq - 2) >> 6; \
    bool wdone = !wactive; \
    const int sr = tid >> 4, sc = (tid & 15) * 8, vst0 = v_st(sr, sc), vst1 = v_st(32 + sr, sc), kst0 = KSWZ(sr, sc * 2), kst1 = KSWZ(32 + sr, sc * 2); \
    const int vb0 = (int)(uintptr_t)V_lds + v_rd_base(lane)

template <int D0> __device__ __forceinline__ void pv_half(f32x16& od, int vb, bf16x8 pa0, bf16x8 pa1) {
    const s16x4 l0 = tr_read<v_rd_off(D0, 0, 0)>(vb), h0 = tr_read<v_rd_off(D0, 0, 1)>(vb), l1 = tr_read<v_rd_off(D0, 1, 0)>(vb), h1 = tr_read<v_rd_off(D0, 1, 1)>(vb);
    asm volatile("s_waitcnt lgkmcnt(0)" ::: "memory"); SBAR();
#define PK(L, H) (bf16x8){L[0], L[1], L[2], L[3], H[0], H[1], H[2], H[3]}
    od = __builtin_amdgcn_mfma_f32_32x32x16_bf16(pa0, PK(l0, h0), od, 0, 0, 0);
    od = __builtin_amdgcn_mfma_f32_32x32x16_bf16(pa1, PK(l1, h1), od, 0, 0, 0);
#undef PK
}
__device__ __forceinline__ void tile_compute32(f32x16 (&o)[4], float& carry, bool& wdone, const bf16x8 (&qr)[8], const char* Kt, int vb, int jt, int qpos, int qmin, int r32, int hi) {
    f32x16 pa = {}, pb = {};
#pragma unroll
    for (int d0 = 0; d0 < 8; d0 += 2) {
        const bf16x8 b0 = *reinterpret_cast<const bf16x8*>(Kt + KSWZ(r32, (d0 * 16 + hi * 8) * 2)), b1 = *reinterpret_cast<const bf16x8*>(Kt + KSWZ(r32, ((d0 + 1) * 16 + hi * 8) * 2));
        pa = __builtin_amdgcn_mfma_f32_32x32x16_bf16(b0, qr[d0], pa, 0, 0, 0);
        pb = __builtin_amdgcn_mfma_f32_32x32x16_bf16(b1, qr[d0 + 1], pb, 0, 0, 0); }
    f32x16 p0 = pa + pb;
    float tl[4];
    if ((32 * jt + 31) >= qmin) sb_block<true>(p0, tl, 32 * jt, qpos, hi); else sb_block<false>(p0, tl, 32 * jt, qpos, hi);
    float Sl[5]; Sl[4] = 1.f;
#pragma unroll
    for (int m = 3; m >= 0; --m) Sl[m] = Sl[m + 1] * tl[m];
#pragma unroll
    for (int m = 0; m < 4; ++m) {
        auto rr = __builtin_amdgcn_permlane32_swap(__float_as_uint(Sl[m]), __float_as_uint(Sl[m + 1]), false, false);
        const float sp = __uint_as_float(hi ? rr[0] : rr[1]);
        const float W = carry * (Sl[m + 1] * sp);
#pragma unroll
        for (int i = 0; i < 4; ++i) p0[4 * m + i] *= W;
    }
    carry *= Sl[0] * partner(Sl[0], hi);
    bf16x8 pa0, pa1;
#define PK4(P, BASE, OUT) do { unsigned a0 = cvt_pk_bf16(P[BASE + 0], P[BASE + 1]), a1 = cvt_pk_bf16(P[BASE + 2], P[BASE + 3]);   \
    unsigned b0 = cvt_pk_bf16(P[BASE + 4], P[BASE + 5]), b1 = cvt_pk_bf16(P[BASE + 6], P[BASE + 7]);                              \
    auto r0 = __builtin_amdgcn_permlane32_swap(a0, b0, false, false); auto r1 = __builtin_amdgcn_permlane32_swap(a1, b1, false, false); \
    u32x4 w = {r0[0], r1[0], r0[1], r1[1]}; OUT = __builtin_bit_cast(bf16x8, w); } while (0)
    PK4(p0, 0, pa0); PK4(p0, 8, pa1);
#undef PK4
    {
#define TR4(D0) const s16x4 l0_##D0 = tr_read<v_rd_off(D0, 0, 0)>(vb), h0_##D0 = tr_read<v_rd_off(D0, 0, 1)>(vb), l1_##D0 = tr_read<v_rd_off(D0, 1, 0)>(vb), h1_##D0 = tr_read<v_rd_off(D0, 1, 1)>(vb)
        TR4(0); TR4(1); TR4(2); TR4(3);
#undef TR4
        asm volatile("s_waitcnt lgkmcnt(0)" ::: "memory"); SBAR();
#define PK(L, H) (bf16x8){L[0], L[1], L[2], L[3], H[0], H[1], H[2], H[3]}
        o[0] = __builtin_amdgcn_mfma_f32_32x32x16_bf16(pa0, PK(l0_0, h0_0), o[0], 0, 0, 0); o[1] = __builtin_amdgcn_mfma_f32_32x32x16_bf16(pa0, PK(l0_1, h0_1), o[1], 0, 0, 0);
        o[2] = __builtin_amdgcn_mfma_f32_32x32x16_bf16(pa0, PK(l0_2, h0_2), o[2], 0, 0, 0); o[3] = __builtin_amdgcn_mfma_f32_32x32x16_bf16(pa0, PK(l0_3, h0_3), o[3], 0, 0, 0);
        o[0] = __builtin_amdgcn_mfma_f32_32x32x16_bf16(pa1, PK(l1_0, h1_0), o[0], 0, 0, 0); o[1] = __builtin_amdgcn_mfma_f32_32x32x16_bf16(pa1, PK(l1_1, h1_1), o[1], 0, 0, 0);
        o[2] = __builtin_amdgcn_mfma_f32_32x32x16_bf16(pa1, PK(l1_2, h1_2), o[2], 0, 0, 0); o[3] = __builtin_amdgcn_mfma_f32_32x32x16_bf16(pa1, PK(l1_3, h1_3), o[3], 0, 0, 0);
#undef PK
    }
    if (__all(carry < 1.17549435e-38f)) wdone = true;
}
constexpr int NBUF = 4, SHM32 = 8192, FLAG_OFF3 = 2 * NBUF * SHM32;
__device__ __forceinline__ void attn_unit_f32(const AttUnit& U, char* lds) {
    const int tid = threadIdx.x, wid = __builtin_amdgcn_readfirstlane(tid >> 6), lane = tid & 63, r32 = lane & 31, hi = lane >> 5;
    char* V_lds = lds; char* K_lds = lds + 2 * SHM32; volatile LAS int* fl = (volatile LAS int*)((LAS char*)lds + 4 * SHM32);
    const bool wactive = wid * 32 < U.nq;
    bf16x8 qr[8];
    { const bf16_t* Qw = U.Q + (size_t)(wactive ? wid * 32 + r32 : r32) * D + hi * 8;
#pragma unroll
      for (int d0 = 0; d0 < 8; ++d0) qr[d0] = *reinterpret_cast<const bf16x8*>(Qw + d0 * 16); }
    f32x16 o[4] = {}; float carry = 1.f;
    const int qpos = U.qpos0 + wid * 32 + r32, qmin = U.qpos0 + wid * 32;
    const int whi = (U.qpos0 + wid * 32 + 30) >> 5, T0 = (U.qpos0 + U.nq - 2) >> 5, nct = U.ncache_tiles * 2;
    bool wdone = !wactive;
    const int sr = tid >> 4, sc = (tid & 15) * 8;
    const int vb0 = (int)(uintptr_t)V_lds + v_rd_base(lane);
    f32x8 vs0, ks0;
#define SLOAD(jt) do { const int _j = (jt); const float* _kp = _j < nct ? U.Kc + (size_t)_j * 32 * D : U.Kn + (size_t)(_j - nct) * 32 * D; \
        const float* _vp = _j < nct ? U.Vc + (size_t)_j * 32 * D : U.Vn + (size_t)(_j - nct) * 32 * D; \
        vs0 = *reinterpret_cast<const f32x8*>(_vp + (size_t)sr * D + sc); ks0 = *reinterpret_cast<const f32x8*>(_kp + (size_t)sr * D + sc); } while (0)
#define SWRITE(b) do { *(bf16x8*)(V_lds + (b) * SHM32 + v_st(sr, sc)) = tobf(vs0); *(bf16x8*)(K_lds + (b) * SHM32 + KSWZ(sr, sc * 2)) = tobf(ks0); } while (0)
    __syncthreads();
    SLOAD(T0); SWRITE(0);
    __syncthreads();
    for (int jt = T0, it = 0;; --jt, ++it) {
        const int cur = it & 1; const bool more = jt > 0;
        if (more) SLOAD(jt - 1);
        if (!wdone && jt <= whi) tile_compute32(o, carry, wdone, qr, K_lds + cur * SHM32, vb0 + cur * SHM32, jt, qpos, qmin, r32, hi);
        if (more) SWRITE(cur ^ 1);
        if (lane == 0) fl[cur * 8 + wid] = wdone ? 1 : 0;
        __syncthreads();
        if (!more) break;
        int alld = 1;
#pragma unroll
        for (int k = 0; k < 8; ++k) alld &= fl[cur * 8 + k];
        if (alld) break;
    }
#undef SLOAD
#undef SWRITE
    if (wactive) attn_store(U, o, wid, r32, hi);
}
struct PUnit { bf16_t* Q; const bf16_t* G; const bf16_t *Kb, *Vb; int qpos0; };
__device__ __forceinline__ PUnit make_punit(int l, bf16_t* Qb, const bf16_t* GAb, const bf16_t* KVb) {
    const int qb = l & 7, h = (l >> 3) & 7, b = l >> 6; const size_t ro = (size_t)(b * T + qb * 256) * D + h * HD;
    PUnit u; u.Q = Qb + ro; u.G = GAb + ro; u.Kb = KVb + (size_t)b * T * D + h * HD; u.Vb = u.Kb + (size_t)MP * D; u.qpos0 = qb * 256; return u;
}
__device__ __forceinline__ void attn_prompt_stream(bf16_t* Qb, const bf16_t* GAb, const bf16_t* KVb, int l0, int lstep, int nl, char* lds) {
    if (l0 >= nl) return;
    const int tid = threadIdx.x, wid = __builtin_amdgcn_readfirstlane(tid >> 6), lane = tid & 63, r32 = lane & 31, hi = lane >> 5;
    char* V_lds = lds; char* K_lds = lds + NBUF * SHM32; volatile LAS int* fl = (volatile LAS int*)((LAS char*)lds + FLAG_OFF3);
    LAS char* ldsl = (LAS char*)lds;
    const int vb0 = (int)(uintptr_t)V_lds + v_rd_base(lane);
    int kOff, vOff;
    { const int G = tid;
      { const int row = G >> 4, gpos = G & 15; kOff = row * D + ((gpos ^ (row & 7)) << 3); }
      { const int sub = G >> 5, kk = (sub >> 2) * 8 + ((G >> 2) & 7), c = (sub & 3) * 32 + (G & 3) * 8, k = (kk & ~0xC) | ((kk & 4) << 1) | ((kk & 8) >> 1); vOff = k * D + c; } }
#define DMA_TILE(jt_, buf_) do { const size_t _o = (size_t)(jt_) * 32 * D; \
        __builtin_amdgcn_global_load_lds((const unsigned*)(U.Vb + _o + vOff), (LAS unsigned*)(ldsl + (buf_) * SHM32 + wid * 1024), 16, 0, 0); \
        __builtin_amdgcn_global_load_lds((const unsigned*)(U.Kb + _o + kOff), (LAS unsigned*)(ldsl + NBUF * SHM32 + (buf_) * SHM32 + wid * 1024), 16, 0, 0); } while (0)
#define UNIT_BEGIN() do { const int _t0 = (U.qpos0 + 254) >> 5; DMA_TILE(_t0, 0); DMA_TILE(_t0 - 1, 1); DMA_TILE(_t0 - 2, 2); \
        const bf16_t* Qw = U.Q + (size_t)(wid * 32 + r32) * D + hi * 8; \
        _Pragma("unroll") for (int d0 = 0; d0 < 8; ++d0) qr[d0] = *reinterpret_cast<const bf16x8*>(Qw + d0 * 16); } while (0)
    PUnit U = make_punit(l0, Qb, GAb, KVb);
    bf16x8 qr[8];
    __syncthreads();
    UNIT_BEGIN();
    for (int l = l0;;) {
        f32x16 o[4] = {}; float carry = 1.f; bool wdone = false;
        const int qpos = U.qpos0 + wid * 32 + r32, qmin = U.qpos0 + wid * 32;
        const int whi = (U.qpos0 + wid * 32 + 30) >> 5, T0 = (U.qpos0 + 254) >> 5;
        int bcur = 0;
        for (int jt = T0, it = 0;; --jt, ++it) {
            asm volatile("s_waitcnt vmcnt(4) lgkmcnt(0)" ::: "memory");
            __builtin_amdgcn_s_barrier();
            asm volatile("" ::: "memory");
            if (it > 0) { int alld = 1;
#pragma unroll
                for (int k = 0; k < 8; ++k) alld &= fl[((it - 1) & 1) * 8 + k];
                if (alld) break; }
            const int bnext = bcur == 0 ? NBUF - 1 : bcur - 1;
            DMA_TILE(jt >= 3 ? jt - 3 : 0, bnext);
            if (!wdone && jt <= whi) tile_compute32(o, carry, wdone, qr, K_lds + bcur * SHM32, vb0 + bcur * SHM32, jt, qpos, qmin, r32, hi);
            if (lane == 0) fl[(it & 1) * 8 + wid] = wdone ? 1 : 0;
            if (jt == 0) break;
            bcur = bcur == NBUF - 1 ? 0 : bcur + 1;
        }
        const int ln = l + lstep; const bool has_next = ln < nl;
        const bf16_t* gcur = U.G; bf16_t* qcur = U.Q;
        asm volatile("s_waitcnt lgkmcnt(0)" ::: "memory");
        __builtin_amdgcn_s_barrier();
        asm volatile("" ::: "memory");
        if (has_next) { U = make_punit(ln, Qb, GAb, KVb); UNIT_BEGIN(); }
        attn_store_p(gcur, qcur, o, wid, r32, hi);
        if (!has_next) break;
        l = ln;
    }
#undef UNIT_BEGIN
#undef DMA_TILE
    asm volatile("s_waitcnt vmcnt(0) lgkmcnt(0)" ::: "memory");
}
}


__device__ __forceinline__ f32x4 small_acc(const bf16_t* __restrict__ Ap, const bf16_t* __restrict__ Bp, int K) {
    f32x4 acc0 = {0.f, 0.f, 0.f, 0.f}, acc1 = {0.f, 0.f, 0.f, 0.f};
#pragma unroll 8
    for (int k = 0; k < K; k += 64) {
        const bf16x8 a0 = *(const bf16x8*)(Ap + k), b0 = *(const bf16x8*)(Bp + k), a1 = *(const bf16x8*)(Ap + k + 32), b1 = *(const bf16x8*)(Bp + k + 32);
        acc0 = __builtin_amdgcn_mfma_f32_16x16x32_bf16(a0, b0, acc0, 0, 0, 0);
        acc1 = __builtin_amdgcn_mfma_f32_16x16x32_bf16(a1, b1, acc1, 0, 0, 0);
    }
    return acc0 + acc1;
}
__device__ __forceinline__ f32x4 small_tile_ksplit(const bf16_t* __restrict__ A, int lda, const bf16_t* __restrict__ Bt, int ldb, int K, LAS float* red, int wave, int lane) {
    const int li = lane & 15, lq = lane >> 4, kw = K >> 3, k0 = wave * kw + lq * 8;
    f32x4 acc[2][4];
#pragma unroll
    for (int by = 0; by < 2; ++by)
#pragma unroll
        for (int bx = 0; bx < 4; ++bx) acc[by][bx] = (f32x4){0.f, 0.f, 0.f, 0.f};
#pragma unroll 4
    for (int ks = 0; ks < kw; ks += 32) {
        bf16x8 a[2], b[4];
#pragma unroll
        for (int by = 0; by < 2; ++by) a[by] = *(const bf16x8*)(A + (size_t)(by * 16 + li) * lda + k0 + ks);
#pragma unroll
        for (int bx = 0; bx < 4; ++bx) b[bx] = *(const bf16x8*)(Bt + (size_t)(bx * 16 + li) * ldb + k0 + ks);
#pragma unroll
        for (int by = 0; by < 2; ++by)
#pragma unroll
            for (int bx = 0; bx < 4; ++bx) acc[by][bx] = __builtin_amdgcn_mfma_f32_16x16x32_bf16(a[by], b[bx], acc[by][bx], 0, 0, 0);
    }
#pragma unroll
    for (int by = 0; by < 2; ++by)
#pragma unroll
        for (int bx = 0; bx < 4; ++bx) *(LAS f32x4*)(red + ((wave * 8 + by * 4 + bx) * 64 + lane) * 4) = acc[by][bx];
    __syncthreads();
    f32x4 r = {0.f, 0.f, 0.f, 0.f};
#pragma unroll
    for (int v = 0; v < 8; ++v) r += *(const LAS f32x4*)(red + ((v * 8 + wave) * 64 + lane) * 4);
    __syncthreads();
    return r;
}
__device__ __forceinline__ float bf2f(bf16_t v) { return __uint_as_float((unsigned)v << 16); }
__device__ __forceinline__ bf16_t f2bf(float v) { return (bf16_t)(cvt_pk_bf16(v, 0.f) & 0xffffu); }

__device__ __forceinline__ void unpack8(const u32x4 g, float* v) {
    v[0] = bf_lo(g.x); v[1] = bf_hi(g.x); v[2] = bf_lo(g.y); v[3] = bf_hi(g.y); v[4] = bf_lo(g.z); v[5] = bf_hi(g.z); v[6] = bf_lo(g.w); v[7] = bf_hi(g.w);
}
template <int W> __device__ __forceinline__ void pool_chunk(const bf16_t* __restrict__ Ub, bf16_t* __restrict__ Pb, const float* __restrict__ state_pool, int row0, int col) {
    constexpr int R = 8, H = W - 1;
    const bool samp = row0 >= MP;
    const int t0 = samp ? ((row0 - MP) & 63) : (row0 & 2047), b = samp ? ((row0 - MP) >> 6) : (row0 >> 11);
    const size_t seq0 = samp ? (size_t)(MP + b * TS) : (size_t)b * T;
    u32x4 raw[H + R];
#pragma unroll
    for (int k = 0; k < H + R; ++k) {
        const int tt = t0 - H + k;
        if (tt >= 0) raw[k] = *(const u32x4*)(Ub + (seq0 + tt) * D + col);
        else if (samp) { const float* sp = state_pool + ((size_t)b * PBUF + (PBUF + tt)) * D + col; const f32x4 a0 = *(const f32x4*)sp, a1 = *(const f32x4*)(sp + 4);
            raw[k] = (u32x4){cvt_pk_bf16(a0[0], a0[1]), cvt_pk_bf16(a0[2], a0[3]), cvt_pk_bf16(a1[0], a1[1]), cvt_pk_bf16(a1[2], a1[3])}; }
        else raw[k] = (u32x4){0u, 0u, 0u, 0u};
    }
    float s8[8];
#pragma unroll
    for (int j = 0; j < 8; ++j) s8[j] = 0.f;
#pragma unroll
    for (int k = 0; k < H; ++k) { float v[8]; unpack8(raw[k], v);
#pragma unroll
        for (int j = 0; j < 8; ++j) s8[j] += v[j]; }
#pragma unroll
    for (int r = 0; r < R; ++r) {
        float cur[8], old[8], pv[8]; unpack8(raw[H + r], cur); unpack8(raw[r], old);
        const int t = t0 + r; const float cnt = samp ? (float)W : (float)(t + 1 < W ? t + 1 : W);
#pragma unroll
        for (int j = 0; j < 8; ++j) { s8[j] += cur[j]; pv[j] = s8[j] / cnt - cur[j]; s8[j] -= old[j]; }
        u32x4 o; o.x = cvt_pk_bf16(pv[0], pv[1]); o.y = cvt_pk_bf16(pv[2], pv[3]); o.z = cvt_pk_bf16(pv[4], pv[5]); o.w = cvt_pk_bf16(pv[6], pv[7]);
        *(u32x4*)(Pb + (size_t)(row0 + r) * D + col) = o;
    }
}

#define XB_TMO      128
#define XB_XCNT(j)  (256  + 64 * (j))
#define XB_XSUB(j)  (1280 + 64 * (j))
#define XB_XGEN(j)  (2304 + 64 * (j))
#define XB_TOP      3328
#define XB_TOPGEN   3392
#define XCD_BAR_WORDS 3456
#define XB_SPIN_CAP (1u << 22)
__device__ __forceinline__ unsigned xb_ld(unsigned* p)              { return __hip_atomic_load(p, __ATOMIC_RELAXED, __HIP_MEMORY_SCOPE_AGENT); }
__device__ __forceinline__ unsigned xb_add(unsigned* p, unsigned v) { return __hip_atomic_fetch_add(p, v, __ATOMIC_RELAXED, __HIP_MEMORY_SCOPE_AGENT); }
__device__ __forceinline__ unsigned xb_xcc_id() { return (unsigned)__builtin_amdgcn_s_getreg((3 << 11) | 20) & 0xFu; }
#define XB_SPIN(cond, bar) do { unsigned _sp = 0; while (cond) { __builtin_amdgcn_s_sleep(1); \
    if ((++_sp & 255u) == 0u) { if (xb_ld(&(bar)[XB_TMO])) break; if (_sp > XB_SPIN_CAP) { atomicAdd(&(bar)[XB_TMO], 1u); break; } } } } while (0)
struct XcdBarrier { unsigned* bar; unsigned x; volatile LAS unsigned* st; };
__device__ __forceinline__ XcdBarrier xcd_barrier_post(unsigned* bar, volatile LAS unsigned* st) {
    XcdBarrier b; b.bar = bar; b.x = xb_xcc_id(); b.st = st;
    if (threadIdx.x == 0) (void)xb_add(&bar[XB_XCNT(b.x)], 1u);
    return b;
}
__device__ __forceinline__ void xcd_barrier_complete(unsigned* bar, unsigned x, unsigned& nloc, unsigned& nx) {
    const unsigned G = gridDim.x * gridDim.y * gridDim.z;
    unsigned sum, cnt, mine, sp = 0u;
    for (;;) {
        sum = 0u; cnt = 0u; mine = 0u;
#pragma unroll
        for (unsigned j = 0; j < 16; ++j) { const unsigned c = xb_ld(&bar[XB_XCNT(j)]); sum += c; cnt += (c > 0u) ? 1u : 0u; mine = (j == x) ? c : mine; }
        if (sum == G) break;
        __builtin_amdgcn_s_sleep(1);
        if ((++sp & 255u) == 0u) { if (xb_ld(&bar[XB_TMO])) break; if (sp > XB_SPIN_CAP) { atomicAdd(&bar[XB_TMO], 1u); break; } }
    }
    nloc = mine > 0u ? mine : 1u; nx = cnt > 0u ? cnt : 1u;
}
__device__ __forceinline__ void xcd_barrier(const XcdBarrier& b) {
    asm volatile("s_waitcnt vmcnt(0)" ::: "memory");
    __syncthreads();
    if (threadIdx.x == 0) {
        unsigned* bar = b.bar;
        __builtin_amdgcn_s_waitcnt(0);
        unsigned nloc = b.st[0], nx = b.st[1];
        if (nloc == 0u) { xcd_barrier_complete(bar, b.x, nloc, nx); b.st[0] = nloc; b.st[1] = nx; }
        const unsigned old = xb_add(&bar[XB_XSUB(b.x)], 1u);
        const unsigned gen = old / nloc;
        if (old + 1u == (gen + 1u) * nloc) {
            __builtin_amdgcn_fence(__ATOMIC_RELEASE, "agent");
            asm volatile("s_waitcnt vmcnt(0)" ::: "memory");
            const unsigned og = xb_add(&bar[XB_TOP], 1u);
            const unsigned tg = og / nx;
            if (og + 1u == (tg + 1u) * nx) xb_add(&bar[XB_TOPGEN], 1u);
            else XB_SPIN(xb_ld(&bar[XB_TOPGEN]) == tg, bar);
            __builtin_amdgcn_fence(__ATOMIC_ACQUIRE, "agent");
            xb_add(&bar[XB_XGEN(b.x)], 1u);
            asm volatile("s_waitcnt vmcnt(0)" ::: "memory");
        } else {
            XB_SPIN(xb_ld(&bar[XB_XGEN(b.x)]) == gen, bar);
            __builtin_amdgcn_fence(__ATOMIC_ACQUIRE, "agent");
            asm volatile("s_waitcnt vmcnt(0)" ::: "memory");
        }
    }
    __syncthreads();
}

struct Args { const float* in[13]; float* out; unsigned char* ws; int ph_lo, ph_hi; };
constexpr int LDS_BYTES = 147456;

__device__ __forceinline__ void p0_transpose_item(const float* W, int K, int N, bf16_t* WT, LAS float* scr, int item, int lane) {
    const int nblk = N / 32, kb = item / nblk, nb = item % nblk, k0 = 64 * kb, n0 = 32 * nb;
#pragma unroll 8
    for (int i = 0; i < 32; ++i) { const int kk = 2 * i + (lane >> 5); scr[kk * 33 + (lane & 31)] = W[(size_t)(k0 + kk) * N + n0 + (lane & 31)]; }
    asm volatile("s_waitcnt lgkmcnt(0)" ::: "memory");
    const int c = lane & 7;
#pragma unroll
    for (int j = 0; j < 4; ++j) { const int n = (lane >> 3) + 8 * j; const LAS float* s = scr + (8 * c) * 33 + n;
        u32x4 o; o.x = cvt_pk_bf16(s[0 * 33], s[1 * 33]); o.y = cvt_pk_bf16(s[2 * 33], s[3 * 33]); o.z = cvt_pk_bf16(s[4 * 33], s[5 * 33]); o.w = cvt_pk_bf16(s[6 * 33], s[7 * 33]);
        *(u32x4*)(WT + (size_t)(n0 + n) * K + k0 + 8 * c) = o; }
    asm volatile("s_waitcnt lgkmcnt(0)" ::: "memory");
}

__global__ void __launch_bounds__(512, 2) fwd_kernel(Args a) {
    extern __shared__ __attribute__((aligned(16))) unsigned char lds[];
    cg::grid_group grid = cg::this_grid();
    const int tid = threadIdx.x, lane = tid & 63, wave = __builtin_amdgcn_readfirstlane(tid >> 6);
    const int G = gridDim.x, bx = blockIdx.x, vcu = (G % 8 == 0) ? (bx % 8) * (G / 8) + bx / 8 : bx;
    unsigned char* ws = a.ws;
    const float *x_p = a.in[0], *x_s = a.in[1], *cache_k = a.in[2], *cache_v = a.in[3], *state_pool = a.in[4], *norm_g = a.in[5], *w_in = a.in[6], *w_pool = a.in[7],
                *pool_scale = a.in[8], *w_br_a = a.in[9], *w_br_b = a.in[10], *w_out = a.in[11], *final_g = a.in[12];
    float* out = a.out;
    float* rowss = (float*)(ws + WS_ROWSS);
    bf16_t *WT_in = (bf16_t*)(ws + WS_WIN), *WT_pool = (bf16_t*)(ws + WS_WPOOL), *WT_bra = (bf16_t*)(ws + WS_WBRA), *WT_brb = (bf16_t*)(ws + WS_WBRB), *WT_out = (bf16_t*)(ws + WS_WOUT);
    bf16_t *Qb = (bf16_t*)(ws + WS_Q), *GAb = (bf16_t*)(ws + WS_GA), *Ub = (bf16_t*)(ws + WS_U), *GBb = (bf16_t*)(ws + WS_GB), *Hb = (bf16_t*)(ws + WS_H), *MGb = (bf16_t*)(ws + WS_MG);
    bf16_t *Pb = Hb, *Mb = Ub;
    LAS unsigned char* ldsl = (LAS unsigned char*)lds;
    const int lo = a.ph_lo, hi_ = a.ph_hi;
    volatile LAS unsigned* MISC = (volatile LAS unsigned*)(ldsl + 131072 + 1024);
    if (tid < 16) MISC[tid] = 0u;
    __syncthreads();
    const XcdBarrier xbar = xcd_barrier_post((unsigned*)(ws + WS_BAR), MISC);
#define IN(k) (lo <= (k) && (k) < hi_)
#define FULLSYNC() do { asm volatile("s_waitcnt vmcnt(0) lgkmcnt(0)" ::: "memory"); grid.sync(); \
        __builtin_amdgcn_fence(__ATOMIC_ACQUIRE, "agent"); asm volatile("s_waitcnt vmcnt(0)" ::: "memory"); __syncthreads(); } while (0)
#define SEAM(k) do { if (IN(k) && IN((k) + 1)) xcd_barrier(xbar); } while (0)

    if (lo < 0) FULLSYNC();

    if (IN(0)) {
        LAS float* scr = (LAS float*)(ldsl + wave * 16384);
        const int gw = vcu * 8 + wave, NGW = G * 8;
        constexpr int I_IN = (D / 64) * (NIN / 32), I_SQ = (D / 64) * (D / 32), I_PL = (256 / 64) * (256 / 32);
        constexpr int NITEMS = I_IN + 3 * I_SQ + 4 * I_PL;
        for (int step = 0; step < 2; ++step) {
        if ((step == 0) == ((wave & 1) == 0)) {
        for (int it = gw; it < NITEMS; it += NGW) {
            int r = it;
            if (r < I_IN) { p0_transpose_item(w_in, D, NIN, WT_in, scr, r, lane); continue; } r -= I_IN;
            if (r < I_SQ) { p0_transpose_item(w_br_a, D, D, WT_bra, scr, r, lane); continue; } r -= I_SQ;
            if (r < I_SQ) { p0_transpose_item(w_br_b, D, D, WT_brb, scr, r, lane); continue; } r -= I_SQ;
            if (r < I_SQ) { p0_transpose_item(w_out, D, D, WT_out, scr, r, lane); continue; } r -= I_SQ;
            const int g = r / I_PL; p0_transpose_item(w_pool + (size_t)g * 65536, 256, 256, WT_pool + (size_t)g * 65536, scr, r % I_PL, lane);
        }
        } else {
        for (int m0 = gw; m0 < MT; m0 += 2 * NGW) {
            const int m1 = m0 + NGW < MT ? m0 + NGW : m0;
            const float* xr0 = m0 < MP ? x_p + (size_t)m0 * D : x_s + (size_t)(m0 - MP) * D; const float* xr1 = m1 < MP ? x_p + (size_t)m1 * D : x_s + (size_t)(m1 - MP) * D;
            const f32x4* gr = (const f32x4*)norm_g + lane;
            f32x4 v0[4], v1[4]; float s0 = 0.f, s1 = 0.f;
#pragma unroll
            for (int j = 0; j < 4; ++j) { v0[j] = ((const f32x4*)xr0 + lane)[64 * j]; v1[j] = ((const f32x4*)xr1 + lane)[64 * j]; }
#pragma unroll
            for (int j = 0; j < 4; ++j) { s0 += (v0[j].x * v0[j].x + v0[j].y * v0[j].y) + (v0[j].z * v0[j].z + v0[j].w * v0[j].w); s1 += (v1[j].x * v1[j].x + v1[j].y * v1[j].y) + (v1[j].z * v1[j].z + v1[j].w * v1[j].w); }
            const float r0 = 1.0f / sqrtf(wave_sum(s0) * (1.f / D) + EPS), r1 = 1.0f / sqrtf(wave_sum(s1) * (1.f / D) + EPS);
            u32x2* o0 = (u32x2*)(Hb + (size_t)m0 * D) + lane; u32x2* o1 = (u32x2*)(Hb + (size_t)m1 * D) + lane;
#pragma unroll
            for (int j = 0; j < 4; ++j) { const f32x4 gv = gr[64 * j]; u32x2 w;
                w.x = cvt_pk_bf16(v0[j].x * r0 * gv.x, v0[j].y * r0 * gv.y); w.y = cvt_pk_bf16(v0[j].z * r0 * gv.z, v0[j].w * r0 * gv.w); o0[64 * j] = w;
                w.x = cvt_pk_bf16(v1[j].x * r1 * gv.x, v1[j].y * r1 * gv.y); w.y = cvt_pk_bf16(v1[j].z * r1 * gv.z, v1[j].w * r1 * gv.w); o1[64 * j] = w; }
        }
        }
        }
        for (int i = bx * 512 + tid; i < MT; i += G * 512) rowss[i] = 0.f;
    }
    SEAM(0);

    if (IN(1)) {
        pg8::Sched S{}; S.nM = MT / 256; S.nN = NIN / 256; S.nwg = S.nM * S.nN; S.G = G; S.c = bx; S.dual = 0;
        S.A0 = S.A1 = (const char*)Hb; S.B0 = S.B1 = (const char*)WT_in; S.a_pm = (size_t)256 * D * 2; S.a_pn = 0; S.b_pn = (size_t)256 * D * 2;
        EpiIn E{Qb, GAb, Ub, GBb, MGb, out};
        pg8::gemm_phase<EpiIn>(ldsl, D, D, D, S, E);
    }
    SEAM(1);

    if (IN(2)) {
        constexpr int NU_S = SB * NH, NU_P = NB * NH * (T / 256), NU = NU_S + NU_P;
        for (int L = vcu; L < NU_S; L += G) {
            att::AttUnit U; const int b = L / NH, h = L % NH; const size_t ro = (size_t)(MP + b * TS) * D + h * HD;
            U.Q = Qb + ro; U.G = GAb + ro;
            U.Kc = cache_k + (size_t)b * PAST * D + h * HD; U.Vc = cache_v + (size_t)b * PAST * D + h * HD;
            U.Kn = out + OFF_KS + (size_t)b * TS * D + h * HD; U.Vn = out + OFF_VS + (size_t)b * TS * D + h * HD;
            U.Kb = U.Vb = nullptr; U.ncache_tiles = PAST / 64; U.qpos0 = PAST; U.nq = TS;
            att::attn_unit_f32(U, (char*)lds);
        }
        { int L0 = vcu; while (L0 < NU_S) L0 += G;
          att::attn_prompt_stream(Qb, GAb, (const bf16_t*)(out + OFF_Y), L0 - NU_S, G, NU_P, (char*)lds); }
        {
            pg8::Sched S3{}; S3.nM = MP / 256; S3.nN = 4; S3.nwg = S3.nM * S3.nN; S3.G = G; S3.c = bx; S3.dual = 0;
            pg8::Unit u;
            for (int i = 0; S3.next(i, u); ++i)
                for (int pass = 0; pass < 2; ++pass) {
                    const int task = pass * 512 + tid, row0 = u.pm * 256 + (task >> 5) * 8, col = u.pn * 256 + (task & 31) * 8;
                    if (u.pn == 0) pool_chunk<2>(Ub, Pb, state_pool, row0, col);
                    else if (u.pn == 1) pool_chunk<4>(Ub, Pb, state_pool, row0, col);
                    else if (u.pn == 2) pool_chunk<8>(Ub, Pb, state_pool, row0, col);
                    else pool_chunk<16>(Ub, Pb, state_pool, row0, col);
                }
            for (int t = vcu; t < 256; t += G)
                if (tid < 128) {
                    const int g = (t & 15) >> 2, row0 = MP + (t >> 4) * 32 + (tid >> 5) * 8, col = g * 256 + (tid & 31) * 8;
                    if (g == 0) pool_chunk<2>(Ub, Pb, state_pool, row0, col);
                    else if (g == 1) pool_chunk<4>(Ub, Pb, state_pool, row0, col);
                    else if (g == 2) pool_chunk<8>(Ub, Pb, state_pool, row0, col);
                    else pool_chunk<16>(Ub, Pb, state_pool, row0, col);
                }
            asm volatile("s_waitcnt vmcnt(0)" ::: "memory");
            __syncthreads();
        }
    }

    if (IN(3)) {
        pg8::Sched S{}; S.nM = MP / 256; S.nN = 4; S.nwg = S.nM * S.nN; S.G = G; S.c = bx; S.dual = 0;
        S.A0 = S.A1 = (const char*)Pb; S.B0 = S.B1 = (const char*)WT_pool; S.a_pm = (size_t)256 * D * 2; S.a_pn = 256 * 2; S.b_pn = (size_t)256 * 256 * 2;
        EpiPool E{GBb, pool_scale};
        pg8::gemm_phase<EpiPool>(ldsl, D, 256, 256, S, E);
        for (int t = vcu; t < 256; t += G) {
            const int r0 = MP + (t >> 4) * 32 + (wave >> 2) * 16, c0 = (t & 15) * 64 + (wave & 3) * 16, g = c0 >> 8, li = lane & 15, lq = lane >> 4;
            const int rt0 = MP + (t >> 4) * 32, ct0 = (t & 15) * 64;
            const f32x4 acc = small_tile_ksplit(Pb + (size_t)rt0 * D + g * 256, D, WT_pool + (size_t)g * 65536 + (size_t)(ct0 - g * 256) * 256, 256, 256, (LAS float*)ldsl, wave, lane);
            const int col = c0 + li; const float sc = pool_scale[col];
#pragma unroll
            for (int j = 0; j < 4; ++j) { bf16_t* p = GBb + (size_t)(r0 + lq * 4 + j) * D + col; *p = f2bf(acc[j] * sc * bf2f(*p)); }
        }
    }
    SEAM(3);

    if (IN(4)) {
        pg8::Sched S{}; S.nM = MP / 256; S.nN = 4; S.nwg = S.nM * S.nN; S.G = G; S.c = bx; S.dual = 1;
        S.A0 = (const char*)Qb; S.A1 = (const char*)GBb; S.B0 = (const char*)WT_bra; S.B1 = (const char*)WT_brb; S.a_pm = (size_t)256 * D * 2; S.a_pn = 0; S.b_pn = (size_t)256 * D * 2;
        EpiBr E{Mb, MGb};
        pg8::gemm_phase<EpiBr>(ldsl, D, D, D, S, E);
        for (int t = vcu; t < 256; t += G) {
            const int r0 = MP + (t >> 4) * 32 + (wave >> 2) * 16, c0 = (t & 15) * 64 + (wave & 3) * 16, li = lane & 15, lq = lane >> 4;
            const int rt0 = MP + (t >> 4) * 32, ct0 = (t & 15) * 64;
            const f32x4 ya = small_tile_ksplit(Qb + (size_t)rt0 * D, D, WT_bra + (size_t)ct0 * D, D, D, (LAS float*)ldsl, wave, lane);
            const f32x4 yb = small_tile_ksplit(GBb + (size_t)rt0 * D, D, WT_brb + (size_t)ct0 * D, D, D, (LAS float*)ldsl, wave, lane);
            const int col = c0 + li;
#pragma unroll
            for (int j = 0; j < 4; ++j) { const size_t row = (size_t)(r0 + lq * 4 + j);
                Mb[row * D + col] = f2bf(bf2f(MGb[row * 2 * D + col]) * ya[j] + bf2f(MGb[row * 2 * D + D + col]) * yb[j]); }
        }
    }
    SEAM(4);

    if (IN(5)) {
        pg8::Sched S{}; S.nM = MP / 256; S.nN = 4; S.nwg = S.nM * S.nN; S.G = G; S.c = bx; S.dual = 0;
        S.A0 = S.A1 = (const char*)Mb; S.B0 = S.B1 = (const char*)WT_out; S.a_pm = (size_t)256 * D * 2; S.a_pn = 0; S.b_pn = (size_t)256 * D * 2;
        EpiOut E{x_p, out + OFF_Y, rowss, (unsigned*)(ws + WS_CNT), final_g};
        pg8::gemm_phase<EpiOut>(ldsl, D, D, D, S, E);
        for (int t = vcu; t < 256; t += G) {
            const int r0 = MP + (t >> 4) * 32 + (wave >> 2) * 16, c0 = (t & 15) * 64 + (wave & 3) * 16, li = lane & 15, lq = lane >> 4;
            const int rt0 = MP + (t >> 4) * 32, ct0 = (t & 15) * 64;
            const f32x4 acc = small_tile_ksplit(Mb + (size_t)rt0 * D, D, WT_out + (size_t)ct0 * D, D, D, (LAS float*)ldsl, wave, lane);
            const int col = c0 + li;
#pragma unroll
            for (int j = 0; j < 4; ++j) { const size_t row = (size_t)(r0 + lq * 4 + j);
                const float v = x_s[(row - MP) * D + col] + acc[j]; Qb[row * D + col] = f2bf(v);
                float ss = v * v; ss += __shfl_xor(ss, 1); ss += __shfl_xor(ss, 2); ss += __shfl_xor(ss, 4); ss += __shfl_xor(ss, 8);
                if (li == 0) atomicAdd(rowss + row, ss); }
        }
    }
    SEAM(5);

    if (IN(6)) {
        const int gw = vcu * 8 + wave, NGW = G * 8;
        for (int m0 = MP + gw; m0 < MT; m0 += 2 * NGW) {
            const int m1 = m0 + NGW < MT ? m0 + NGW : m0;
            const u32x2* xr0 = (const u32x2*)(Qb + (size_t)m0 * D) + lane; const u32x2* xr1 = (const u32x2*)(Qb + (size_t)m1 * D) + lane;
            f32x4* yr0 = (f32x4*)(out + OFF_Y + (size_t)m0 * D) + lane; f32x4* yr1 = (f32x4*)(out + OFF_Y + (size_t)m1 * D) + lane; const f32x4* gr = (const f32x4*)final_g + lane;
            u32x2 w0[4], w1[4];
#pragma unroll
            for (int j = 0; j < 4; ++j) { w0[j] = xr0[64 * j]; w1[j] = xr1[64 * j]; }
            const float r0 = 1.0f / sqrtf(__hip_atomic_load(rowss + m0, __ATOMIC_RELAXED, __HIP_MEMORY_SCOPE_AGENT) * (1.f / D) + EPS);
            const float r1 = 1.0f / sqrtf(__hip_atomic_load(rowss + m1, __ATOMIC_RELAXED, __HIP_MEMORY_SCOPE_AGENT) * (1.f / D) + EPS);
#pragma unroll
            for (int j = 0; j < 4; ++j) { const f32x4 gv = gr[64 * j];
                const f32x4 a = {bf_lo(w0[j].x), bf_hi(w0[j].x), bf_lo(w0[j].y), bf_hi(w0[j].y)}, b = {bf_lo(w1[j].x), bf_hi(w1[j].x), bf_lo(w1[j].y), bf_hi(w1[j].y)};
                yr0[64 * j] = a * r0 * gv; yr1[64 * j] = b * r1 * gv; }
        }
    }
#undef IN
#undef SEAM
}

extern "C" void kernel_launch(void* const* d_in, const int* in_sizes, int n_in, void* d_out, int out_size, void* d_ws, size_t ws_size, hipStream_t stream) {
    static int grid = 0;
    if (grid == 0) {
        if (n_in != 13 || in_sizes[0] != MP * D || (size_t)out_size != OFF_PS + (size_t)SB * PBUF * D || ws_size < WS_END) {
            fprintf(stderr, "kernel_launch: unexpected shapes: n_in %d in0 %d out %d ws %zu (need %zu)\n", n_in, n_in > 0 ? in_sizes[0] : -1, out_size, ws_size, (size_t)WS_END); grid = -1; return; }
        int dev = 0, cus = 0, per_cu = 0;
        if (hipGetDevice(&dev) != hipSuccess || hipDeviceGetAttribute(&cus, hipDeviceAttributeMultiprocessorCount, dev) != hipSuccess) { grid = -1; return; }
        if (hipFuncSetAttribute((const void*)fwd_kernel, hipFuncAttributeMaxDynamicSharedMemorySize, LDS_BYTES) != hipSuccess) { fprintf(stderr, "kernel_launch: hipFuncSetAttribute failed\n"); grid = -1; return; }
        if (hipOccupancyMaxActiveBlocksPerMultiprocessor(&per_cu, (const void*)fwd_kernel, 512, LDS_BYTES) != hipSuccess || per_cu < 1) { fprintf(stderr, "kernel_launch: occupancy query failed (%d)\n", per_cu); grid = -1; return; }
        grid = cus * per_cu;
    }
    if (grid < 0) return;
    if (hipMemsetAsync((char*)d_ws + WS_BAR, 0, WS_BAR_BYTES, stream) != hipSuccess) { fprintf(stderr, "kernel_launch: memset failed\n"); return; }
    Args a{};
    for (int i = 0; i < 13; ++i) a.in[i] = (const float*)d_in[i];
    a.out = (float*)d_out; a.ws = (unsigned char*)d_ws; a.ph_lo = 0; a.ph_hi = 7;
    void* args[] = {&a};
    const hipError_t e = hipLaunchCooperativeKernel((const void*)fwd_kernel, dim3(grid), dim3(512), args, LDS_BYTES, stream);
    if (e != hipSuccess) fprintf(stderr, "kernel_launch: cooperative launch failed: %s (grid %d)\n", hipGetErrorString(e), grid);
}
```

```cpp
#include <hip/hip_runtime.h>
#include <hip/hip_cooperative_groups.h>
#include <cstdio>
#include <cstdint>
namespace cg = cooperative_groups;

constexpr int D = 1024, NB = 16, T = 2048, SB = 8, TS = 64, PAST = 4096, NH = 8, HD = 128;
constexpr int MP = NB * T, MS = SB * TS, MT = MP + MS;
constexpr int NIN = 8192;
constexpr int PBUF = 15;
constexpr float EPS = 1e-6f;
constexpr float QSCALE = 0.12751743082459868f;
constexpr size_t OFF_Y = 0, OFF_KP = (size_t)MT * D, OFF_VP = OFF_KP + (size_t)MP * D, OFF_PP = OFF_VP + (size_t)MP * D,
                 OFF_KS = OFF_PP + (size_t)NB * PBUF * D, OFF_VS = OFF_KS + (size_t)MS * D, OFF_PS = OFF_VS + (size_t)MS * D;
constexpr size_t MiB = 1u << 20, RB = (size_t)MT * D * 2;
constexpr size_t WS_ROWSS = 0, WS_BAR = 512 * 1024, WS_CNT = WS_BAR + 16384, WS_BAR_BYTES = 16384 + 1024, WS_WIN = 1 * MiB, WS_WPOOL = 17 * MiB, WS_WBRA = 18 * MiB, WS_WBRB = 20 * MiB, WS_WOUT = 22 * MiB;
constexpr size_t WS_Q = 24 * MiB, WS_GA = WS_Q + RB, WS_U = WS_GA + RB, WS_GB = WS_U + RB, WS_H = WS_GB + RB, WS_MG = WS_H + RB, WS_END = WS_MG + 2 * RB;

#define LAS __attribute__((address_space(3)))
typedef unsigned short bf16_t;
typedef short bf16x8 __attribute__((ext_vector_type(8)));
typedef short s16x4 __attribute__((ext_vector_type(4)));
typedef float f32x4 __attribute__((ext_vector_type(4)));
typedef float f32x8 __attribute__((ext_vector_type(8)));
typedef float f32x16 __attribute__((ext_vector_type(16)));
typedef unsigned u32x4 __attribute__((ext_vector_type(4)));
typedef unsigned u32x2 __attribute__((ext_vector_type(2)));

typedef float f32x2_t __attribute__((ext_vector_type(2)));
typedef __bf16 bf16x2_t __attribute__((ext_vector_type(2)));
__device__ __forceinline__ unsigned cvt_pk_bf16(float lo, float hi) { const f32x2_t v = {lo, hi}; const bf16x2_t b = __builtin_convertvector(v, bf16x2_t); return __builtin_bit_cast(unsigned, b); }
__device__ __forceinline__ float bf_lo(unsigned w) { return __uint_as_float(w << 16); }
__device__ __forceinline__ float bf_hi(unsigned w) { return __uint_as_float(w & 0xffff0000u); }
__device__ __forceinline__ float sigmoidf_(float v) { return __builtin_amdgcn_rcpf(1.0f + __builtin_amdgcn_exp2f(-1.4426950408889634f * v)); }
__device__ __forceinline__ float wave_sum(float v) {
#pragma unroll
    for (int o = 1; o < 64; o <<= 1) v += __shfl_xor(v, o);
    return v;
}

namespace pg8 {
constexpr int BM = 256, BK = 64, HALF = 128, HTB = HALF * BK * 2, STAGE_BYTES = 8 * HTB, NXCD = 8, WGM = 8;
__device__ __forceinline__ int lds_byte(int r, int c) { const int st = (r >> 4) * 2 + (c >> 5), rr = r & 15, cc = c & 31, ob = rr * 64 + cc * 2; return st * 1024 + (ob ^ (((ob >> 9) & 1) << 5)); }
__device__ __forceinline__ void stage_rc(int b, int& R, int& C) { const int st = b / 1024, sb = b % 1024, swz = sb ^ (((sb >> 9) & 1) << 5); R = (st >> 1) * 16 + swz / 64; C = (st & 1) * 32 + (swz % 64) / 2; }
__device__ __forceinline__ int perm32(int rho) { const int n = rho >> 4, i = rho & 15; return 8 * (i >> 2) + 4 * n + (i & 3); }

struct Unit { int pm, pn, br; };
struct Sched {
    int nM, nN, nwg, G, c, dual;
    const char *A0, *A1, *B0, *B1; size_t a_pm, a_pn, b_pn;
    __device__ __forceinline__ bool next(int i, Unit& u) const {
        const int rnd = dual ? (i >> 1) : i;
        const long L = (long)rnd * G + c; if (L >= nwg) return false;
        int wgid = (int)L; { const int q = nwg / NXCD, r = nwg % NXCD, xcd = wgid % NXCD, off = wgid / NXCD; wgid = (xcd < r ? xcd * (q + 1) : r * (q + 1) + (xcd - r) * q) + off; }
        const int nig = WGM * nN, gid = wgid / nig, fm = gid * WGM, gsz = (nM - fm) < WGM ? (nM - fm) : WGM;
        u.pm = fm + ((wgid % nig) % gsz); u.pn = (wgid % nig) / gsz; u.br = dual ? (i & 1) : 0; return true;
    }
    __device__ __forceinline__ const char* abase(const Unit& u) const { return (u.br ? A1 : A0) + (size_t)u.pm * a_pm + (size_t)u.pn * a_pn; }
    __device__ __forceinline__ const char* bbase(const Unit& u) const { return (u.br ? B1 : B0) + (size_t)u.pn * b_pn; }
};

template <class Epi>
__device__ __forceinline__ void gemm_phase(LAS unsigned char* lds, const int lda, const int ldb, const int K, const Sched& S, const Epi& E) {
    const int tid = threadIdx.x, wid = __builtin_amdgcn_readfirstlane(tid >> 6), lane = tid & 63, wr = wid >> 2, wc = wid & 3, fr = lane & 15, fq = lane >> 4;
    const int nt = K / BK;
    unsigned voffA[2], voffB[2];
#pragma unroll
    for (int i = 0; i < 2; ++i) { int R, C; stage_rc(tid * 16 + i * 8192, R, C); const int Rb = (R & ~31) + perm32(R & 31);
        voffA[i] = (unsigned)(R * lda + C) * 2u; voffB[i] = (unsigned)(Rb * ldb + C) * 2u; }
    const size_t kstep = (size_t)(BK * 2);
    const size_t hstepA = (size_t)HALF * lda * 2, hstepB = (size_t)HALF * ldb * 2;
    const unsigned ldsw = (unsigned)wid * 1024u;
    const int aoff = lds_byte(wr * 64 + fr, fq * 8), boff = lds_byte(wc * 32 + fr, fq * 8);
#define PG8_SA(b, h) (((b) * 2 + (h)) * HTB)
#define PG8_SB(b, h) ((4 + (b) * 2 + (h)) * HTB)
#define PG8_STAGE(bufoff, gbase, voff) do { _Pragma("unroll") for (int _i = 0; _i < 2; ++_i) \
        __builtin_amdgcn_global_load_lds((const unsigned*)((const char*)(gbase) + (voff)[_i]), (LAS unsigned*)(lds + (bufoff) + ldsw + _i * 8192), 16, 0, 0); } while (0)
#define PG8_LDA(dst, b, h) do { _Pragma("unroll") for (int m = 0; m < 4; ++m) _Pragma("unroll") for (int k = 0; k < 2; ++k) dst[m][k] = *(const LAS bf16x8*)(lds + PG8_SA(b, h) + aoff + m * 2048 + k * 1024); } while (0)
#define PG8_LDB(dst, b, h) do { _Pragma("unroll") for (int n = 0; n < 2; ++n) _Pragma("unroll") for (int k = 0; k < 2; ++k) dst[n][k] = *(const LAS bf16x8*)(lds + PG8_SB(b, h) + boff + n * 2048 + k * 1024); } while (0)
#define PG8_MMA(ai, bj, At, Bt) do { __builtin_amdgcn_s_setprio(1); _Pragma("unroll") for (int m = 0; m < 4; ++m) _Pragma("unroll") for (int n = 0; n < 2; ++n) _Pragma("unroll") for (int k = 0; k < 2; ++k) \
        acc[ai][bj][m][n] = __builtin_amdgcn_mfma_f32_16x16x32_bf16(Bt[n][k], At[m][k], acc[ai][bj][m][n], 0, 0, 0); __builtin_amdgcn_s_setprio(0); } while (0)
#define PG8_WAIT_V(n) asm volatile("s_waitcnt vmcnt(" #n ")" ::: "memory")
#define PG8_WAIT_L(n) asm volatile("s_waitcnt lgkmcnt(" #n ")" ::: "memory")
#define PG8_BAR __builtin_amdgcn_s_barrier()
#define PG8_SCHED __builtin_amdgcn_sched_barrier(0)
    Unit cur, nxt; int ui = 0;
    if (!S.next(0, cur)) return;
    f32x4 acc[2][2][4][2];
#pragma unroll
    for (int a = 0; a < 2; ++a)
#pragma unroll
        for (int b = 0; b < 2; ++b)
#pragma unroll
            for (int m = 0; m < 4; ++m)
#pragma unroll
                for (int n = 0; n < 2; ++n) acc[a][b][m][n] = (f32x4){0.f, 0.f, 0.f, 0.f};
    bf16x8 At[4][2], B0[2][2], B1[2][2];
    const char* cA = S.abase(cur); const char* cB = S.bbase(cur);
    PG8_STAGE(PG8_SB(0, 0), cB, voffB); PG8_STAGE(PG8_SB(0, 1), cB + hstepB, voffB); PG8_STAGE(PG8_SA(0, 0), cA, voffA); PG8_STAGE(PG8_SA(0, 1), cA + hstepA, voffA);
    if (wr == 1) PG8_BAR;
    PG8_WAIT_V(2); PG8_BAR;
    PG8_STAGE(PG8_SB(1, 0), cB + kstep, voffB); PG8_STAGE(PG8_SA(1, 0), cA + kstep, voffA); PG8_STAGE(PG8_SB(1, 1), cB + hstepB + kstep, voffB);
    PG8_WAIT_V(6); PG8_BAR;
    for (;;) {
        const bool has_next = S.next(ui + 1, nxt);
        const char* nA = has_next ? S.abase(nxt) : cA; const char* nB = has_next ? S.bbase(nxt) : cB;
#pragma unroll 1
        for (int t = 0; t < nt; t += 2) {
            const bool last = (t == nt - 2);
            const char* a1 = cA + (size_t)(t + 1) * kstep;
            const char* a2 = last ? nA : cA + (size_t)(t + 2) * kstep; const char* b2 = last ? nB : cB + (size_t)(t + 2) * kstep;
            const char* a3 = a2 + kstep; const char* b3 = b2 + kstep;
            PG8_LDB(B0, 0, 0); PG8_LDB(B1, 0, 1); PG8_SCHED; PG8_LDA(At, 0, 0); PG8_STAGE(PG8_SA(1, 1), a1 + hstepA, voffA);
            PG8_WAIT_V(8); PG8_WAIT_L(0); PG8_BAR; PG8_MMA(0, 0, At, B0); PG8_MMA(0, 1, At, B1); PG8_BAR; PG8_SCHED;
            PG8_LDA(At, 0, 1); PG8_STAGE(PG8_SB(0, 0), b2, voffB); PG8_STAGE(PG8_SB(0, 1), b2 + hstepB, voffB); PG8_STAGE(PG8_SA(0, 0), a2, voffA);
            PG8_WAIT_V(8); PG8_WAIT_L(0); PG8_BAR; PG8_MMA(1, 0, At, B0); PG8_MMA(1, 1, At, B1); PG8_BAR; PG8_SCHED;
            PG8_LDB(B0, 1, 0); PG8_LDB(B1, 1, 1); PG8_SCHED; PG8_LDA(At, 1, 0); PG8_STAGE(PG8_SA(0, 1), a2 + hstepA, voffA);
            PG8_WAIT_V(8); PG8_WAIT_L(0); PG8_BAR; PG8_MMA(0, 0, At, B0); PG8_MMA(0, 1, At, B1); PG8_BAR; PG8_SCHED;
            PG8_LDA(At, 1, 1); PG8_STAGE(PG8_SB(1, 0), b3, voffB); PG8_STAGE(PG8_SB(1, 1), b3 + hstepB, voffB); PG8_STAGE(PG8_SA(1, 0), a3, voffA);
            PG8_WAIT_V(8); PG8_WAIT_L(0); PG8_BAR; PG8_MMA(1, 0, At, B0); PG8_MMA(1, 1, At, B1); PG8_BAR; PG8_SCHED;
        }
        if (wr == 0) PG8_BAR;
        const bool keep = E(acc, cur, wr, wc, fr, fq);
        if (!has_next) break;
        if (!keep) {
#pragma unroll
        for (int a = 0; a < 2; ++a)
#pragma unroll
            for (int b = 0; b < 2; ++b)
#pragma unroll
                for (int m = 0; m < 4; ++m)
#pragma unroll
                    for (int n = 0; n < 2; ++n) acc[a][b][m][n] = (f32x4){0.f, 0.f, 0.f, 0.f};
        }
        cur = nxt; cA = nA; cB = nB; ++ui;
        if (wr == 1) PG8_BAR;
    }
    PG8_WAIT_V(0);
    PG8_BAR;
#undef PG8_SA
#undef PG8_SB
#undef PG8_STAGE
#undef PG8_LDA
#undef PG8_LDB
#undef PG8_MMA
#undef PG8_WAIT_V
#undef PG8_WAIT_L
#undef PG8_BAR
#undef PG8_SCHED
}
}

typedef f32x4 AccT[2][2][4][2];
#define EPI_ROWS(u) const int row0 = (u).pm * 256 + wr * 64 + fr
#define EPI_FOR_AI_M _Pragma("unroll") for (int ai = 0; ai < 2; ++ai) _Pragma("unroll") for (int m = 0; m < 4; ++m)

__device__ __forceinline__ u32x4 pack8(const f32x4 v0, const f32x4 v1) {
    u32x4 w; w.x = cvt_pk_bf16(v0[0], v0[1]); w.y = cvt_pk_bf16(v0[2], v0[3]); w.z = cvt_pk_bf16(v1[0], v1[1]); w.w = cvt_pk_bf16(v1[2], v1[3]); return w;
}
template <int ACT> __device__ __forceinline__ f32x4 act4(f32x4 v) {
    f32x4 o;
#pragma unroll
    for (int j = 0; j < 4; ++j) { const float x = v[j]; o[j] = ACT == 0 ? x * QSCALE : ACT == 1 ? x * sigmoidf_(x) : ACT == 2 ? sigmoidf_(x) : x; }
    return o;
}
template <int ACT> __device__ __forceinline__ void store_bf16_tile(const AccT& acc, bf16_t* base, int ld, int row0, int col0) {
    EPI_FOR_AI_M { bf16_t* rowp = base + (size_t)(row0 + ai * 128 + m * 16) * ld + col0;
#pragma unroll
        for (int bj = 0; bj < 2; ++bj) *(u32x4*)(rowp + bj * 128) = pack8(act4<ACT>(acc[ai][bj][m][0]), act4<ACT>(acc[ai][bj][m][1])); }
}
struct EpiIn {
    bf16_t *Q, *GA, *U, *GB, *MG; float* out;
    __device__ __forceinline__ bool operator()(AccT& acc, const pg8::Unit& u, int wr, int wc, int fr, int fq) const {
        EPI_ROWS(u);
        const int sec = u.pn >> 2, col0 = (u.pn & 3) * 256 + wc * 32 + 8 * fq;
        if (sec == 0) store_bf16_tile<0>(acc, Q, D, row0, col0);
        else if (sec == 3) store_bf16_tile<1>(acc, GA, D, row0, col0);
        else if (sec == 5) store_bf16_tile<1>(acc, GB, D, row0, col0);
        else if (sec >= 6) store_bf16_tile<2>(acc, MG, 2 * D, row0, (sec - 6) * D + col0);
        else if (sec == 4) {
            store_bf16_tile<3>(acc, U, D, row0, col0);
            const bool samp = u.pm >= MP / 256;
            if (samp || (u.pm & 7) == 7) {
                EPI_FOR_AI_M { const int row = row0 + ai * 128 + m * 16; int b, tt; float* pb;
                    if (samp) { b = (row - MP) >> 6; tt = ((row - MP) & 63) - (TS - PBUF); pb = out + OFF_PS; } else { b = row >> 11; tt = (row & 2047) - (T - PBUF); pb = out + OFF_PP; }
                    if (tt >= 0) { float* rp = pb + ((size_t)b * PBUF + tt) * D + col0;
#pragma unroll
                        for (int bj = 0; bj < 2; ++bj) { *(f32x4*)(rp + bj * 128) = acc[ai][bj][m][0]; *(f32x4*)(rp + bj * 128 + 4) = acc[ai][bj][m][1]; } } }
            }
        } else {
            const bool samp = u.pm >= MP / 256;
            float* base = out + (sec == 1 ? (samp ? OFF_KS : OFF_KP) : (samp ? OFF_VS : OFF_VP));
            const int r0 = samp ? row0 - MP : row0;
            EPI_FOR_AI_M { float* rp = base + (size_t)(r0 + ai * 128 + m * 16) * D + col0;
#pragma unroll
                for (int bj = 0; bj < 2; ++bj) { *(f32x4*)(rp + bj * 128) = acc[ai][bj][m][0]; *(f32x4*)(rp + bj * 128 + 4) = acc[ai][bj][m][1]; } }
            if (!samp) {
                bf16_t* kvb = (bf16_t*)(out + OFF_Y) + (sec == 1 ? (size_t)0 : (size_t)MP * D);
                store_bf16_tile<3>(acc, kvb, D, row0, col0);
            }
        }
        return false;
    }
};
struct EpiPool {
    bf16_t* GB; const float* scale;
    __device__ __forceinline__ bool operator()(AccT& acc, const pg8::Unit& u, int wr, int wc, int fr, int fq) const {
        EPI_ROWS(u); const int col0 = u.pn * 256 + wc * 32 + 8 * fq;
        EPI_FOR_AI_M { bf16_t* rowp = GB + (size_t)(row0 + ai * 128 + m * 16) * D + col0;
#pragma unroll
            for (int bj = 0; bj < 2; ++bj) { const u32x4 g = *(const u32x4*)(rowp + bj * 128);
                f32x4 v0 = acc[ai][bj][m][0] * *(const f32x4*)(scale + col0 + bj * 128), v1 = acc[ai][bj][m][1] * *(const f32x4*)(scale + col0 + bj * 128 + 4);
                v0 = v0 * (f32x4){bf_lo(g.x), bf_hi(g.x), bf_lo(g.y), bf_hi(g.y)}; v1 = v1 * (f32x4){bf_lo(g.z), bf_hi(g.z), bf_lo(g.w), bf_hi(g.w)};
                *(u32x4*)(rowp + bj * 128) = pack8(v0, v1); } }
        return false;
    }
};
struct EpiBr {
    bf16_t* M; const bf16_t* MG;
    __device__ __forceinline__ bool operator()(AccT& acc, const pg8::Unit& u, int wr, int wc, int fr, int fq) const {
        EPI_ROWS(u); const int col0 = u.pn * 256 + wc * 32 + 8 * fq;
        if (u.br == 0) {
            EPI_FOR_AI_M { const size_t row = (size_t)(row0 + ai * 128 + m * 16); const bf16_t* gp = MG + row * (2 * D) + col0;
#pragma unroll
                for (int bj = 0; bj < 2; ++bj) { const u32x4 ga = *(const u32x4*)(gp + bj * 128), gb = *(const u32x4*)(gp + D + bj * 128);
                    const f32x4 a0 = {bf_lo(ga.x), bf_hi(ga.x), bf_lo(ga.y), bf_hi(ga.y)}, a1 = {bf_lo(ga.z), bf_hi(ga.z), bf_lo(ga.w), bf_hi(ga.w)};
                    const f32x4 b0 = {bf_lo(gb.x), bf_hi(gb.x), bf_lo(gb.y), bf_hi(gb.y)}, b1 = {bf_lo(gb.z), bf_hi(gb.z), bf_lo(gb.w), bf_hi(gb.w)};
#pragma unroll
                    for (int j = 0; j < 4; ++j) { acc[ai][bj][m][0][j] *= a0[j] * __builtin_amdgcn_rcpf(fmaxf(b0[j], 1e-35f)); acc[ai][bj][m][1][j] *= a1[j] * __builtin_amdgcn_rcpf(fmaxf(b1[j], 1e-35f)); } } }
            return true;
        }
        EPI_FOR_AI_M { const size_t row = (size_t)(row0 + ai * 128 + m * 16); bf16_t* rowp = M + row * D + col0; const bf16_t* gp = MG + row * (2 * D) + D + col0;
#pragma unroll
            for (int bj = 0; bj < 2; ++bj) { const u32x4 g = *(const u32x4*)(gp + bj * 128);
                const f32x4 v0 = acc[ai][bj][m][0] * (f32x4){bf_lo(g.x), bf_hi(g.x), bf_lo(g.y), bf_hi(g.y)}, v1 = acc[ai][bj][m][1] * (f32x4){bf_lo(g.z), bf_hi(g.z), bf_lo(g.w), bf_hi(g.w)};
                *(u32x4*)(rowp + bj * 128) = pack8(v0, v1); } }
        return false;
    }
};
struct EpiOut {
    const float* xp; float* y; float* rowss; unsigned* cnt; const float* fg;
    __device__ __forceinline__ bool operator()(AccT& acc, const pg8::Unit& u, int wr, int wc, int fr, int fq) const {
        EPI_ROWS(u); const int col0 = u.pn * 256 + wc * 32 + 8 * fq;
        EPI_FOR_AI_M { const size_t row = (size_t)(row0 + ai * 128 + m * 16); const float* xr = xp + row * D + col0; float ss = 0.f;
#pragma unroll
            for (int bj = 0; bj < 2; ++bj) { const f32x4 a = *(const f32x4*)(xr + bj * 128) + acc[ai][bj][m][0], b = *(const f32x4*)(xr + bj * 128 + 4) + acc[ai][bj][m][1];
                acc[ai][bj][m][0] = a; acc[ai][bj][m][1] = b;
                ss += (a[0] * a[0] + a[1] * a[1]) + (a[2] * a[2] + a[3] * a[3]) + (b[0] * b[0] + b[1] * b[1]) + (b[2] * b[2] + b[3] * b[3]); }
            ss += __shfl_xor(ss, 16); ss += __shfl_xor(ss, 32);
            if (fq == 0) atomicAdd(rowss + row, ss); }
        asm volatile("s_waitcnt vmcnt(0)" ::: "memory");
        __builtin_amdgcn_s_barrier(); asm volatile("" ::: "memory");
        if (threadIdx.x == 0) {
            __hip_atomic_fetch_add(cnt + u.pm, 1u, __ATOMIC_RELAXED, __HIP_MEMORY_SCOPE_AGENT);
            unsigned sp = 0;
            while (__hip_atomic_load(cnt + u.pm, __ATOMIC_RELAXED, __HIP_MEMORY_SCOPE_AGENT) < 4u) { __builtin_amdgcn_s_sleep(1); if (++sp > (1u << 22)) break; }
            __builtin_amdgcn_fence(__ATOMIC_ACQUIRE, "agent");
            asm volatile("s_waitcnt vmcnt(0)" ::: "memory");
        }
        __builtin_amdgcn_s_barrier(); asm volatile("" ::: "memory");
        EPI_FOR_AI_M { const size_t row = (size_t)(row0 + ai * 128 + m * 16); float* yr = y + row * D + col0;
            const float rstd = 1.0f / sqrtf(__hip_atomic_load(rowss + row, __ATOMIC_RELAXED, __HIP_MEMORY_SCOPE_AGENT) * (1.f / D) + EPS);
#pragma unroll
            for (int bj = 0; bj < 2; ++bj) { const f32x4 g0 = *(const f32x4*)(fg + col0 + bj * 128), g1 = *(const f32x4*)(fg + col0 + bj * 128 + 4);
                *(f32x4*)(yr + bj * 128) = acc[ai][bj][m][0] * rstd * g0; *(f32x4*)(yr + bj * 128 + 4) = acc[ai][bj][m][1] * rstd * g1; } }
        return false;
    }
};

namespace att {
constexpr int SHM_K = 16384, SHM_V = 16384, FLAG_OFF = 65536;
#define KSWZ(row, colB) ((row) * 256 + ((colB) ^ (((row) & 7) << 4)))
#define SBAR() __builtin_amdgcn_sched_barrier(0)
__device__ __forceinline__ int crow(int r, int hi) { return (r & 3) + 8 * (r >> 2) + 4 * hi; }
__device__ __forceinline__ bf16x8 tobf(f32x8 x) { u32x4 w = {cvt_pk_bf16(x[0], x[1]), cvt_pk_bf16(x[2], x[3]), cvt_pk_bf16(x[4], x[5]), cvt_pk_bf16(x[6], x[7])}; return __builtin_bit_cast(bf16x8, w); }
__device__ __forceinline__ void qkt(f32x16& p0, f32x16& p1, const char* Ks, const bf16x8* qr, int r32, int hi) {
    p0 = f32x16{}; p1 = f32x16{};
#pragma unroll
    for (int d0 = 0; d0 < 8; ++d0) { const int cb = (d0 * 16 + hi * 8) * 2;
        const bf16x8 b0 = *reinterpret_cast<const bf16x8*>(Ks + KSWZ(r32, cb));
        const bf16x8 b1 = *reinterpret_cast<const bf16x8*>(Ks + KSWZ(32 + r32, cb));
        p0 = __builtin_amdgcn_mfma_f32_32x32x16_bf16(b0, qr[d0], p0, 0, 0, 0);
        p1 = __builtin_amdgcn_mfma_f32_32x32x16_bf16(b1, qr[d0], p1, 0, 0, 0); }
}
__device__ __forceinline__ int v_st(int k, int c) { const int kk = (k & ~0xC) | ((k & 4) << 1) | ((k & 8) >> 1); return ((kk >> 3) * 4 + (c >> 5)) * 512 + ((kk & 7) * 32 + (c & 31)) * 2; }
__device__ __forceinline__ int v_rd_base(int lane) { return ((lane & 3) << 3) | (((lane >> 2) & 3) << 6) | (((lane >> 4) & 1) << 5) | (((lane >> 5) & 1) << 8); }
constexpr int v_rd_off(int d0, int ks, int half) { return d0 * 512 + ks * 4096 + half * 2048; }
template <int OFF> __device__ __forceinline__ s16x4 tr_read(int vb) { s16x4 r; asm volatile("ds_read_b64_tr_b16 %0, %1 offset:%2" : "=&v"(r) : "v"(vb), "i"(OFF) : "memory"); return r; }
template <int D0> __device__ __forceinline__ void pv_one(f32x16& od, int vb, bf16x8 pa0, bf16x8 pa1, bf16x8 pa2, bf16x8 pa3) {
    const s16x4 l0 = tr_read<v_rd_off(D0, 0, 0)>(vb), h0 = tr_read<v_rd_off(D0, 0, 1)>(vb), l1 = tr_read<v_rd_off(D0, 1, 0)>(vb), h1 = tr_read<v_rd_off(D0, 1, 1)>(vb);
    const s16x4 l2 = tr_read<v_rd_off(D0, 2, 0)>(vb), h2 = tr_read<v_rd_off(D0, 2, 1)>(vb), l3 = tr_read<v_rd_off(D0, 3, 0)>(vb), h3 = tr_read<v_rd_off(D0, 3, 1)>(vb);
    asm volatile("s_waitcnt lgkmcnt(0)" ::: "memory"); SBAR();
#define PK(L, H) (bf16x8){L[0], L[1], L[2], L[3], H[0], H[1], H[2], H[3]}
    od = __builtin_amdgcn_mfma_f32_32x32x16_bf16(pa0, PK(l0, h0), od, 0, 0, 0);
    od = __builtin_amdgcn_mfma_f32_32x32x16_bf16(pa1, PK(l1, h1), od, 0, 0, 0);
    od = __builtin_amdgcn_mfma_f32_32x32x16_bf16(pa2, PK(l2, h2), od, 0, 0, 0);
    od = __builtin_amdgcn_mfma_f32_32x32x16_bf16(pa3, PK(l3, h3), od, 0, 0, 0);
#undef PK
}
__device__ __forceinline__ float partner(float x, int hi) {
    auto rr = __builtin_amdgcn_permlane32_swap(__float_as_uint(x), __float_as_uint(x), false, false);
    return __uint_as_float(hi ? rr[0] : rr[1]);
}
template <bool MASK> __device__ __forceinline__ void sb_block(f32x16& p, float* tl, int keybase, int qpos, int hi) {
#pragma unroll
    for (int m = 0; m < 4; ++m) {
        float b[4], c[4];
#pragma unroll
        for (int i = 0; i < 4; ++i) {
            const float e = __builtin_amdgcn_exp2f(-__builtin_fmaxf(p[4 * m + i], -126.f)), r = __builtin_amdgcn_rcpf(1.0f + e);
            b[i] = r; c[i] = e * r;
            if (MASK) { const bool masked = (keybase + 8 * m + 4 * hi + i) >= qpos; b[i] = masked ? 0.f : b[i]; c[i] = masked ? 1.f : c[i]; }
        }
        const float x2 = c[3], x1 = c[3] * c[2], x0 = x1 * c[1];
        p[4 * m + 3] = b[3]; p[4 * m + 2] = b[2] * x2; p[4 * m + 1] = b[1] * x1; p[4 * m + 0] = b[0] * x0;
        tl[m] = x0 * c[0];
    }
}

struct AttUnit { bf16_t* Q; const bf16_t* G; const float *Kc, *Vc, *Kn, *Vn; const bf16_t *Kb, *Vb; int ncache_tiles, qpos0, nq; };

__device__ __forceinline__ void tile_compute(f32x16 (&o)[4], float& carry, bool& wdone, const bf16x8 (&qr)[8], const char* Kt, int vb, int jt, int qpos, int qmin, int r32, int hi) {
    f32x16 p0, p1;
    qkt(p0, p1, Kt, qr, r32, hi);
    const bool need_mask = (64 * jt + 63) >= qmin;
    float tl[8];
    if (need_mask) { sb_block<true>(p0, tl, 64 * jt, qpos, hi); sb_block<true>(p1, tl + 4, 64 * jt + 32, qpos, hi); }
    else { sb_block<false>(p0, tl, 64 * jt, qpos, hi); sb_block<false>(p1, tl + 4, 64 * jt + 32, qpos, hi); }
    float Sl[9]; Sl[8] = 1.f;
#pragma unroll
    for (int m = 7; m >= 0; --m) Sl[m] = Sl[m + 1] * tl[m];
#pragma unroll
    for (int m = 0; m < 8; ++m) {
        auto rr = __builtin_amdgcn_permlane32_swap(__float_as_uint(Sl[m]), __float_as_uint(Sl[m + 1]), false, false);
        const float sp = __uint_as_float(hi ? rr[0] : rr[1]);
        const float W = carry * (Sl[m + 1] * sp);
        if (m < 4) {
#pragma unroll
            for (int i = 0; i < 4; ++i) p0[4 * m + i] *= W;
        } else {
#pragma unroll
            for (int i = 0; i < 4; ++i) p1[4 * (m - 4) + i] *= W;
        }
    }
    carry *= Sl[0] * partner(Sl[0], hi);
    bf16x8 pa0, pa1, pa2, pa3;
#define PK4(P, BASE, OUT) do { unsigned a0 = cvt_pk_bf16(P[BASE + 0], P[BASE + 1]), a1 = cvt_pk_bf16(P[BASE + 2], P[BASE + 3]);   \
    unsigned b0 = cvt_pk_bf16(P[BASE + 4], P[BASE + 5]), b1 = cvt_pk_bf16(P[BASE + 6], P[BASE + 7]);                              \
    auto r0 = __builtin_amdgcn_permlane32_swap(a0, b0, false, false); auto r1 = __builtin_amdgcn_permlane32_swap(a1, b1, false, false); \
    u32x4 w = {r0[0], r1[0], r0[1], r1[1]}; OUT = __builtin_bit_cast(bf16x8, w); } while (0)
    PK4(p0, 0, pa0); PK4(p0, 8, pa1); PK4(p1, 0, pa2); PK4(p1, 8, pa3);
#undef PK4
    pv_one<0>(o[0], vb, pa0, pa1, pa2, pa3); pv_one<1>(o[1], vb, pa0, pa1, pa2, pa3); pv_one<2>(o[2], vb, pa0, pa1, pa2, pa3); pv_one<3>(o[3], vb, pa0, pa1, pa2, pa3);
    if (__all(carry < 1.17549435e-38f)) wdone = true;
}
__device__ __forceinline__ void attn_store_p(const bf16_t* __restrict__ gp, bf16_t* __restrict__ qp, const f32x16 (&o)[4], int wid, int r32, int hi) {
#pragma unroll
    for (int dh = 0; dh < 2; ++dh) {
        unsigned short g[2][16];
#pragma unroll
        for (int d1 = 0; d1 < 2; ++d1)
#pragma unroll
            for (int r = 0; r < 16; ++r) g[d1][r] = gp[(size_t)(wid * 32 + crow(r, hi)) * D + r32 + (2 * dh + d1) * 32];
#pragma unroll
        for (int d1 = 0; d1 < 2; ++d1)
#pragma unroll
            for (int r = 0; r < 16; ++r) { const float gv = __uint_as_float((unsigned)g[d1][r] << 16);
                qp[(size_t)(wid * 32 + crow(r, hi)) * D + r32 + (2 * dh + d1) * 32] = (bf16_t)(cvt_pk_bf16(o[2 * dh + d1][r] * gv, 0.f) & 0xffffu); }
    }
}
__device__ __forceinline__ void attn_store(const AttUnit& U, const f32x16 (&o)[4], int wid, int r32, int hi) { attn_store_p(U.G, U.Q, o, wid, r32, hi); }
#define ATT_COMMON() \
    const int tid = threadIdx.x, wid = __builtin_amdgcn_readfirstlane(tid >> 6), lane = tid & 63, r32 = lane & 31, hi = lane >> 5; \
    char* V_lds = lds; char* K_lds = lds + 2 * SHM_V; volatile LAS int* fl = (volatile LAS int*)((LAS char*)lds + FLAG_OFF); \
    const bool wactive = wid * 32 < U.nq; \
    bf16x8 qr[8]; \
    { const bf16_t* Qw = U.Q + (size_t)(wactive ? wid * 32 + r32 : r32) * D + hi * 8; \
      _Pragma("unroll") for (int d0 = 0; d0 < 8; ++d0) qr[d0] = *reinterpret_cast<const bf16x8*>(Qw + d0 * 16); } \
    f32x16 o[4] = {}; float carry = 1.f; \
    const int qpos = U.qpos0 + wid * 32 + r32, qmin = U.qpos0 + wid * 32; \
    const int whi = (U.qpos0 + wid * 32 + 30) >> 6, T0 = (U.qpos0 + U.nq - 2) >> 6; \
    bool wdone = !wactive; \
    const int sr = tid >> 4, sc = (tid & 15) * 8, vst0 = v_st(sr, sc), vst1 = v_st(32 + sr, sc), kst0 = KSWZ(sr, sc * 2), kst1 = KSWZ(32 + sr, sc * 2); \
    const int vb0 = (int)(uintptr_t)V_lds + v_rd_base(lane)

template <int D0> __device__ __forceinline__ void pv_half(f32x16& od, int vb, bf16x8 pa0, bf16x8 pa1) {
    const s16x4 l0 = tr_read<v_rd_off(D0, 0, 0)>(vb), h0 = tr_read<v_rd_off(D0, 0, 1)>(vb), l1 = tr_read<v_rd_off(D0, 1, 0)>(vb), h1 = tr_read<v_rd_off(D0, 1, 1)>(vb);
    asm volatile("s_waitcnt lgkmcnt(0)" ::: "memory"); SBAR();
#define PK(L, H) (bf16x8){L[0], L[1], L[2], L[3], H[0], H[1], H[2], H[3]}
    od = __builtin_amdgcn_mfma_f32_32x32x16_bf16(pa0, PK(l0, h0), od, 0, 0, 0);
    od = __builtin_amdgcn_mfma_f32_32x32x16_bf16(pa1, PK(l1, h1), od, 0, 0, 0);
#undef PK
}
__device__ __forceinline__ void tile_compute32(f32x16 (&o)[4], float& carry, bool& wdone, const bf16x8 (&qr)[8], const char* Kt, int vb, int jt, int qpos, int qmin, int r32, int hi) {
    f32x16 pa = {}, pb = {};
#pragma unroll
    for (int d0 = 0; d0 < 8; d0 += 2) {
        const bf16x8 b0 = *reinterpret_cast<const bf16x8*>(Kt + KSWZ(r32, (d0 * 16 + hi * 8) * 2)), b1 = *reinterpret_cast<const bf16x8*>(Kt + KSWZ(r32, ((d0 + 1) * 16 + hi * 8) * 2));
        pa = __builtin_amdgcn_mfma_f32_32x32x16_bf16(b0, qr[d0], pa, 0, 0, 0);
        pb = __builtin_amdgcn_mfma_f32_32x32x16_bf16(b1, qr[d0 + 1], pb, 0, 0, 0); }
    f32x16 p0 = pa + pb;
    float tl[4];
    if ((32 * jt + 31) >= qmin) sb_block<true>(p0, tl, 32 * jt, qpos, hi); else sb_block<false>(p0, tl, 32 * jt, qpos, hi);
    float Sl[5]; Sl[4] = 1.f;
#pragma unroll
    for (int m = 3; m >= 0; --m) Sl[m] = Sl[m + 1] * tl[m];
#pragma unroll
    for (int m = 0; m < 4; ++m) {
        auto rr = __builtin_amdgcn_permlane32_swap(__float_as_uint(Sl[m]), __float_as_uint(Sl[m + 1]), false, false);
        const float sp = __uint_as_float(hi ? rr[0] : rr[1]);
        const float W = carry * (Sl[m + 1] * sp);
#pragma unroll
        for (int i = 0; i < 4; ++i) p0[4 * m + i] *= W;
    }
    carry *= Sl[0] * partner(Sl[0], hi);
    bf16x8 pa0, pa1;
#define PK4(P, BASE, OUT) do { unsigned a0 = cvt_pk_bf16(P[BASE + 0], P[BASE + 1]), a1 = cvt_pk_bf16(P[BASE + 2], P[BASE + 3]);   \
    unsigned b0 = cvt_pk_bf16(P[BASE + 4], P[BASE + 5]), b1 = cvt_pk_bf16(P[BASE + 6], P[BASE + 7]);                              \
    auto r0 = __builtin_amdgcn_permlane32_swap(a0, b0, false, false); auto r1 = __builtin_amdgcn_permlane32_swap(a1, b1, false, false); \
    u32x4 w = {r0[0], r1[0], r0[1], r1[1]}; OUT = __builtin_bit_cast(bf16x8, w); } while (0)
    PK4(p0, 0, pa0); PK4(p0, 8, pa1);
#undef PK4
    {
#define TR4(D0) const s16x4 l0_##D0 = tr_read<v_rd_off(D0, 0, 0)>(vb), h0_##D0 = tr_read<v_rd_off(D0, 0, 1)>(vb), l1_##D0 = tr_read<v_rd_off(D0, 1, 0)>(vb), h1_##D0 = tr_read<v_rd_off(D0, 1, 1)>(vb)
        TR4(0); TR4(1); TR4(2); TR4(3);
#undef TR4
        asm volatile("s_waitcnt lgkmcnt(0)" ::: "memory"); SBAR();
#define PK(L, H) (bf16x8){L[0], L[1], L[2], L[3], H[0], H[1], H[2], H[3]}
        o[0] = __builtin_amdgcn_mfma_f32_32x32x16_bf16(pa0, PK(l0_0, h0_0), o[0], 0, 0, 0); o[1] = __builtin_amdgcn_mfma_f32_32x32x16_bf16(pa0, PK(l0_1, h0_1), o[1], 0, 0, 0);
        o[2] = __builtin_amdgcn_mfma_f32_32x32x16_bf16(pa0, PK(l0_2, h0_2), o[2], 0, 0, 0); o[3] = __builtin_amdgcn_mfma_f32_32x32x16_bf16(pa0, PK(l0_3, h0_3), o[3], 0, 0, 0);
        o[0] = __builtin_amdgcn_mfma_f32_32x32x16_bf16(pa1, PK(l1_0, h1_0), o[0], 0, 0, 0); o[1] = __builtin_amdgcn_mfma_f32_32x32x16_bf16(pa1, PK(l1_1, h1_1), o[1], 0, 0, 0);
        o[2] = __builtin_amdgcn_mfma_f32_32x32x16_bf16(pa1, PK(l1_2, h1_2), o[2], 0, 0, 0); o[3] = __builtin_amdgcn_mfma_f32_32x32x16_bf16(pa1, PK(l1_3, h1_3), o[3], 0, 0, 0);
#undef PK
    }
    if (__all(carry < 1.17549435e-38f)) wdone = true;
}
constexpr int NBUF = 4, SHM32 = 8192, FLAG_OFF3 = 2 * NBUF * SHM32;
__device__ __forceinline__ void attn_unit_f32(const AttUnit& U, char* lds) {
    const int tid = threadIdx.x, wid = __builtin_amdgcn_readfirstlane(tid >> 6), lane = tid & 63, r32 = lane & 31, hi = lane >> 5;
    char* V_lds = lds; char* K_lds = lds + 2 * SHM32; volatile LAS int* fl = (volatile LAS int*)((LAS char*)lds + 4 * SHM32);
    const bool wactive = wid * 32 < U.nq;
    bf16x8 qr[8];
    { const bf16_t* Qw = U.Q + (size_t)(wactive ? wid * 32 + r32 : r32) * D + hi * 8;
#pragma unroll
      for (int d0 = 0; d0 < 8; ++d0) qr[d0] = *reinterpret_cast<const bf16x8*>(Qw + d0 * 16); }
    f32x16 o[4] = {}; float carry = 1.f;
    const int qpos = U.qpos0 + wid * 32 + r32, qmin = U.qpos0 + wid * 32;
    const int whi = (U.qpos0 + wid * 32 + 30) >> 5, T0 = (U.qpos0 + U.nq - 2) >> 5, nct = U.ncache_tiles * 2;
    bool wdone = !wactive;
    const int sr = tid >> 4, sc = (tid & 15) * 8;
    const int vb0 = (int)(uintptr_t)V_lds + v_rd_base(lane);
    f32x8 vs0, ks0;
#define SLOAD(jt) do { const int _j = (jt); const float* _kp = _j < nct ? U.Kc + (size_t)_j * 32 * D : U.Kn + (size_t)(_j - nct) * 32 * D; \
        const float* _vp = _j < nct ? U.Vc + (size_t)_j * 32 * D : U.Vn + (size_t)(_j - nct) * 32 * D; \
        vs0 = *reinterpret_cast<const f32x8*>(_vp + (size_t)sr * D + sc); ks0 = *reinterpret_cast<const f32x8*>(_kp + (size_t)sr * D + sc); } while (0)
#define SWRITE(b) do { *(bf16x8*)(V_lds + (b) * SHM32 + v_st(sr, sc)) = tobf(vs0); *(bf16x8*)(K_lds + (b) * SHM32 + KSWZ(sr, sc * 2)) = tobf(ks0); } while (0)
    __syncthreads();
    SLOAD(T0); SWRITE(0);
    __syncthreads();
    for (int jt = T0, it = 0;; --jt, ++it) {
        const int cur = it & 1; const bool more = jt > 0;
        if (more) SLOAD(jt - 1);
        if (!wdone && jt <= whi) tile_compute32(o, carry, wdone, qr, K_lds + cur * SHM32, vb0 + cur * SHM32, jt, qpos, qmin, r32, hi);
        if (more) SWRITE(cur ^ 1);
        if (lane == 0) fl[cur * 8 + wid] = wdone ? 1 : 0;
        __syncthreads();
        if (!more) break;
        int alld = 1;
#pragma unroll
        for (int k = 0; k < 8; ++k) alld &= fl[cur * 8 + k];
        if (alld) break;
    }
#undef SLOAD
#undef SWRITE
    if (wactive) attn_store(U, o, wid, r32, hi);
}
struct PUnit { bf16_t* Q; const bf16_t* G; const bf16_t *Kb, *Vb; int qpos0; };
__device__ __forceinline__ PUnit make_punit(int l, bf16_t* Qb, const bf16_t* GAb, const bf16_t* KVb) {
    const int qb = l & 7, h = (l >> 3) & 7, b = l >> 6; const size_t ro = (size_t)(b * T + qb * 256) * D + h * HD;
    PUnit u; u.Q = Qb + ro; u.G = GAb + ro; u.Kb = KVb + (size_t)b * T * D + h * HD; u.Vb = u.Kb + (size_t)MP * D; u.qpos0 = qb * 256; return u;
}
__device__ __forceinline__ void attn_prompt_stream(bf16_t* Qb, const bf16_t* GAb, const bf16_t* KVb, int l0, int lstep, int nl, char* lds) {
    if (l0 >= nl) return;
    const int tid = threadIdx.x, wid = __builtin_amdgcn_readfirstlane(tid >> 6), lane = tid & 63, r32 = lane & 31, hi = lane >> 5;
    char* V_lds = lds; char* K_lds = lds + NBUF * SHM32; volatile LAS int* fl = (volatile LAS int*)((LAS char*)lds + FLAG_OFF3);
    LAS char* ldsl = (LAS char*)lds;
    const int vb0 = (int)(uintptr_t)V_lds + v_rd_base(lane);
    int kOff, vOff;
    { const int G = tid;
      { const int row = G >> 4, gpos = G & 15; kOff = row * D + ((gpos ^ (row & 7)) << 3); }
      { const int sub = G >> 5, kk = (sub >> 2) * 8 + ((G >> 2) & 7), c = (sub & 3) * 32 + (G & 3) * 8, k = (kk & ~0xC) | ((kk & 4) << 1) | ((kk & 8) >> 1); vOff = k * D + c; } }
#define DMA_TILE(jt_, buf_) do { const size_t _o = (size_t)(jt_) * 32 * D; \
        __builtin_amdgcn_global_load_lds((const unsigned*)(U.Vb + _o + vOff), (LAS unsigned*)(ldsl + (buf_) * SHM32 + wid * 1024), 16, 0, 0); \
        __builtin_amdgcn_global_load_lds((const unsigned*)(U.Kb + _o + kOff), (LAS unsigned*)(ldsl + NBUF * SHM32 + (buf_) * SHM32 + wid * 1024), 16, 0, 0); } while (0)
#define UNIT_BEGIN() do { const int _t0 = (U.qpos0 + 254) >> 5; DMA_TILE(_t0, 0); DMA_TILE(_t0 - 1, 1); DMA_TILE(_t0 - 2, 2); \
        const bf16_t* Qw = U.Q + (size_t)(wid * 32 + r32) * D + hi * 8; \
        _Pragma("unroll") for (int d0 = 0; d0 < 8; ++d0) qr[d0] = *reinterpret_cast<const bf16x8*>(Qw + d0 * 16); } while (0)
    PUnit U = make_punit(l0, Qb, GAb, KVb);
    bf16x8 qr[8];
    __syncthreads();
    UNIT_BEGIN();
    for (int l = l0;;) {
        f32x16 o[4] = {}; float carry = 1.f; bool wdone = false;
        const int qpos = U.qpos0 + wid * 32 + r32, qmin = U.qpos0 + wid * 32;
        const int whi = (U.qpos0 + wid * 32 + 30) >> 5, T0 = (U.qpos0 + 254) >> 5;
        int bcur = 0;
        for (int jt = T0, it = 0;; --jt, ++it) {
            asm volatile("s_waitcnt vmcnt(4) lgkmcnt(0)" ::: "memory");
            __builtin_amdgcn_s_barrier();
            asm volatile("" ::: "memory");
            if (it > 0) { int alld = 1;
#pragma unroll
                for (int k = 0; k < 8; ++k) alld &= fl[((it - 1) & 1) * 8 + k];
                if (alld) break; }
            const int bnext = bcur == 0 ? NBUF - 1 : bcur - 1;
            DMA_TILE(jt >= 3 ? jt - 3 : 0, bnext);
            if (!wdone && jt <= whi) tile_compute32(o, carry, wdone, qr, K_lds + bcur * SHM32, vb0 + bcur * SHM32, jt, qpos, qmin, r32, hi);
            if (lane == 0) fl[(it & 1) * 8 + wid] = wdone ? 1 : 0;
            if (jt == 0) break;
            bcur = bcur == NBUF - 1 ? 0 : bcur + 1;
        }
        const int ln = l + lstep; const bool has_next = ln < nl;
        const bf16_t* gcur = U.G; bf16_t* qcur = U.Q;
        asm volatile("s_waitcnt lgkmcnt(0)" ::: "memory");
        __builtin_amdgcn_s_barrier();
        asm volatile("" ::: "memory");
        if (has_next) { U = make_punit(ln, Qb, GAb, KVb); UNIT_BEGIN(); }
        attn_store_p(gcur, qcur, o, wid, r32, hi);
        if (!has_next) break;
        l = ln;
    }
#undef UNIT_BEGIN
#undef DMA_TILE
    asm volatile("s_waitcnt vmcnt(0) lgkmcnt(0)" ::: "memory");
}
}


__device__ __forceinline__ f32x4 small_acc(const bf16_t* __restrict__ Ap, const bf16_t* __restrict__ Bp, int K) {
    f32x4 acc0 = {0.f, 0.f, 0.f, 0.f}, acc1 = {0.f, 0.f, 0.f, 0.f};
#pragma unroll 8
    for (int k = 0; k < K; k += 64) {
        const bf16x8 a0 = *(const bf16x8*)(Ap + k), b0 = *(const bf16x8*)(Bp + k), a1 = *(const bf16x8*)(Ap + k + 32), b1 = *(const bf16x8*)(Bp + k + 32);
        acc0 = __builtin_amdgcn_mfma_f32_16x16x32_bf16(a0, b0, acc0, 0, 0, 0);
        acc1 = __builtin_amdgcn_mfma_f32_16x16x32_bf16(a1, b1, acc1, 0, 0, 0);
    }
    return acc0 + acc1;
}
__device__ __forceinline__ f32x4 small_tile_ksplit(const bf16_t* __restrict__ A, int lda, const bf16_t* __restrict__ Bt, int ldb, int K, LAS float* red, int wave, int lane) {
    const int li = lane & 15, lq = lane >> 4, kw = K >> 3, k0 = wave * kw + lq * 8;
    f32x4 acc[2][4];
#pragma unroll
    for (int by = 0; by < 2; ++by)
#pragma unroll
        for (int bx = 0; bx < 4; ++bx) acc[by][bx] = (f32x4){0.f, 0.f, 0.f, 0.f};
#pragma unroll 4
    for (int ks = 0; ks < kw; ks += 32) {
        bf16x8 a[2], b[4];
#pragma unroll
        for (int by = 0; by < 2; ++by) a[by] = *(const bf16x8*)(A + (size_t)(by * 16 + li) * lda + k0 + ks);
#pragma unroll
        for (int bx = 0; bx < 4; ++bx) b[bx] = *(const bf16x8*)(Bt + (size_t)(bx * 16 + li) * ldb + k0 + ks);
#pragma unroll
        for (int by = 0; by < 2; ++by)
#pragma unroll
            for (int bx = 0; bx < 4; ++bx) acc[by][bx] = __builtin_amdgcn_mfma_f32_16x16x32_bf16(a[by], b[bx], acc[by][bx], 0, 0, 0);
    }
#pragma unroll
    for (int by = 0; by < 2; ++by)
#pragma unroll
        for (int bx = 0; bx < 4; ++bx) *(LAS f32x4*)(red + ((wave * 8 + by * 4 + bx) * 64 + lane) * 4) = acc[by][bx];
    __syncthreads();
    f32x4 r = {0.f, 0.f, 0.f, 0.f};
#pragma unroll
    for (int v = 0; v < 8; ++v) r += *(const LAS f32x4*)(red + ((v * 8 + wave) * 64 + lane) * 4);
    __syncthreads();
    return r;
}
__device__ __forceinline__ float bf2f(bf16_t v) { return __uint_as_float((unsigned)v << 16); }
__device__ __forceinline__ bf16_t f2bf(float v) { return (bf16_t)(cvt_pk_bf16(v, 0.f) & 0xffffu); }

__device__ __forceinline__ void unpack8(const u32x4 g, float* v) {
    v[0] = bf_lo(g.x); v[1] = bf_hi(g.x); v[2] = bf_lo(g.y); v[3] = bf_hi(g.y); v[4] = bf_lo(g.z); v[5] = bf_hi(g.z); v[6] = bf_lo(g.w); v[7] = bf_hi(g.w);
}
template <int W> __device__ __forceinline__ void pool_chunk(const bf16_t* __restrict__ Ub, bf16_t* __restrict__ Pb, const float* __restrict__ state_pool, int row0, int col) {
    constexpr int R = 8, H = W - 1;
    const bool samp = row0 >= MP;
    const int t0 = samp ? ((row0 - MP) & 63) : (row0 & 2047), b = samp ? ((row0 - MP) >> 6) : (row0 >> 11);
    const size_t seq0 = samp ? (size_t)(MP + b * TS) : (size_t)b * T;
    u32x4 raw[H + R];
#pragma unroll
    for (int k = 0; k < H + R; ++k) {
        const int tt = t0 - H + k;
        if (tt >= 0) raw[k] = *(const u32x4*)(Ub + (seq0 + tt) * D + col);
        else if (samp) { const float* sp = state_pool + ((size_t)b * PBUF + (PBUF + tt)) * D + col; const f32x4 a0 = *(const f32x4*)sp, a1 = *(const f32x4*)(sp + 4);
            raw[k] = (u32x4){cvt_pk_bf16(a0[0], a0[1]), cvt_pk_bf16(a0[2], a0[3]), cvt_pk_bf16(a1[0], a1[1]), cvt_pk_bf16(a1[2], a1[3])}; }
        else raw[k] = (u32x4){0u, 0u, 0u, 0u};
    }
    float s8[8];
#pragma unroll
    for (int j = 0; j < 8; ++j) s8[j] = 0.f;
#pragma unroll
    for (int k = 0; k < H; ++k) { float v[8]; unpack8(raw[k], v);
#pragma unroll
        for (int j = 0; j < 8; ++j) s8[j] += v[j]; }
#pragma unroll
    for (int r = 0; r < R; ++r) {
        float cur[8], old[8], pv[8]; unpack8(raw[H + r], cur); unpack8(raw[r], old);
        const int t = t0 + r; const float cnt = samp ? (float)W : (float)(t + 1 < W ? t + 1 : W);
#pragma unroll
        for (int j = 0; j < 8; ++j) { s8[j] += cur[j]; pv[j] = s8[j] / cnt - cur[j]; s8[j] -= old[j]; }
        u32x4 o; o.x = cvt_pk_bf16(pv[0], pv[1]); o.y = cvt_pk_bf16(pv[2], pv[3]); o.z = cvt_pk_bf16(pv[4], pv[5]); o.w = cvt_pk_bf16(pv[6], pv[7]);
        *(u32x4*)(Pb + (size_t)(row0 + r) * D + col) = o;
    }
}

#define XB_TMO      128
#define XB_XCNT(j)  (256  + 64 * (j))
#define XB_XSUB(j)  (1280 + 64 * (j))
#define XB_XGEN(j)  (2304 + 64 * (j))
#define XB_TOP      3328
#define XB_TOPGEN   3392
#define XCD_BAR_WORDS 3456
#define XB_SPIN_CAP (1u << 22)
__device__ __forceinline__ unsigned xb_ld(unsigned* p)              { return __hip_atomic_load(p, __ATOMIC_RELAXED, __HIP_MEMORY_SCOPE_AGENT); }
__device__ __forceinline__ unsigned xb_add(unsigned* p, unsigned v) { return __hip_atomic_fetch_add(p, v, __ATOMIC_RELAXED, __HIP_MEMORY_SCOPE_AGENT); }
__device__ __forceinline__ unsigned xb_xcc_id() { return (unsigned)__builtin_amdgcn_s_getreg((3 << 11) | 20) & 0xFu; }
#define XB_SPIN(cond, bar) do { unsigned _sp = 0; while (cond) { __builtin_amdgcn_s_sleep(1); \
    if ((++_sp & 255u) == 0u) { if (xb_ld(&(bar)[XB_TMO])) break; if (_sp > XB_SPIN_CAP) { atomicAdd(&(bar)[XB_TMO], 1u); break; } } } } while (0)
struct XcdBarrier { unsigned* bar; unsigned x; volatile LAS unsigned* st; };
__device__ __forceinline__ XcdBarrier xcd_barrier_post(unsigned* bar, volatile LAS unsigned* st) {
    XcdBarrier b; b.bar = bar; b.x = xb_xcc_id(); b.st = st;
    if (threadIdx.x == 0) (void)xb_add(&bar[XB_XCNT(b.x)], 1u);
    return b;
}
__device__ __forceinline__ void xcd_barrier_complete(unsigned* bar, unsigned x, unsigned& nloc, unsigned& nx) {
    const unsigned G = gridDim.x * gridDim.y * gridDim.z;
    unsigned sum, cnt, mine, sp = 0u;
    for (;;) {
        sum = 0u; cnt = 0u; mine = 0u;
#pragma unroll
        for (unsigned j = 0; j < 16; ++j) { const unsigned c = xb_ld(&bar[XB_XCNT(j)]); sum += c; cnt += (c > 0u) ? 1u : 0u; mine = (j == x) ? c : mine; }
        if (sum == G) break;
        __builtin_amdgcn_s_sleep(1);
        if ((++sp & 255u) == 0u) { if (xb_ld(&bar[XB_TMO])) break; if (sp > XB_SPIN_CAP) { atomicAdd(&bar[XB_TMO], 1u); break; } }
    }
    nloc = mine > 0u ? mine : 1u; nx = cnt > 0u ? cnt : 1u;
}
__device__ __forceinline__ void xcd_barrier(const XcdBarrier& b) {
    asm volatile("s_waitcnt vmcnt(0)" ::: "memory");
    __syncthreads();
    if (threadIdx.x == 0) {
        unsigned* bar = b.bar;
        __builtin_amdgcn_s_waitcnt(0);
        unsigned nloc = b.st[0], nx = b.st[1];
        if (nloc == 0u) { xcd_barrier_complete(bar, b.x, nloc, nx); b.st[0] = nloc; b.st[1] = nx; }
        const unsigned old = xb_add(&bar[XB_XSUB(b.x)], 1u);
        const unsigned gen = old / nloc;
        if (old + 1u == (gen + 1u) * nloc) {
            __builtin_amdgcn_fence(__ATOMIC_RELEASE, "agent");
            asm volatile("s_waitcnt vmcnt(0)" ::: "memory");
            const unsigned og = xb_add(&bar[XB_TOP], 1u);
            const unsigned tg = og / nx;
            if (og + 1u == (tg + 1u) * nx) xb_add(&bar[XB_TOPGEN], 1u);
            else XB_SPIN(xb_ld(&bar[XB_TOPGEN]) == tg, bar);
            __builtin_amdgcn_fence(__ATOMIC_ACQUIRE, "agent");
            xb_add(&bar[XB_XGEN(b.x)], 1u);
            asm volatile("s_waitcnt vmcnt(0)" ::: "memory");
        } else {
            XB_SPIN(xb_ld(&bar[XB_XGEN(b.x)]) == gen, bar);
            __builtin_amdgcn_fence(__ATOMIC_ACQUIRE, "agent");
            asm volatile("s_waitcnt vmcnt(0)" ::: "memory");
        }
    }
    __syncthreads();
}

struct Args { const float* in[13]; float* out; unsigned char* ws; int ph_lo, ph_hi; };
constexpr int LDS_BYTES = 147456;

__device__ __forceinline__ void p0_transpose_item(const float* W, int K, int N, bf16_t* WT, LAS float* scr, int item, int lane) {
    const int nblk = N / 32, kb = item / nblk, nb = item % nblk, k0 = 64 * kb, n0 = 32 * nb;
#pragma unroll 8
    for (int i = 0; i < 32; ++i) { const int kk = 2 * i + (lane >> 5); scr[kk * 33 + (lane & 31)] = __builtin_nontemporal_load(&W[(size_t)(k0 + kk) * N + n0 + (lane & 31)]); }
    asm volatile("s_waitcnt lgkmcnt(0)" ::: "memory");
    const int c = lane & 7;
#pragma unroll
    for (int j = 0; j < 4; ++j) { const int n = (lane >> 3) + 8 * j; const LAS float* s = scr + (8 * c) * 33 + n;
        u32x4 o; o.x = cvt_pk_bf16(s[0 * 33], s[1 * 33]); o.y = cvt_pk_bf16(s[2 * 33], s[3 * 33]); o.z = cvt_pk_bf16(s[4 * 33], s[5 * 33]); o.w = cvt_pk_bf16(s[6 * 33], s[7 * 33]);
        *(u32x4*)(WT + (size_t)(n0 + n) * K + k0 + 8 * c) = o; }
    asm volatile("s_waitcnt lgkmcnt(0)" ::: "memory");
}

__global__ void __launch_bounds__(512, 2) fwd_kernel(Args a) {
    extern __shared__ __attribute__((aligned(16))) unsigned char lds[];
    cg::grid_group grid = cg::this_grid();
    const int tid = threadIdx.x, lane = tid & 63, wave = __builtin_amdgcn_readfirstlane(tid >> 6);
    const int G = gridDim.x, bx = blockIdx.x, vcu = (G % 8 == 0) ? (bx % 8) * (G / 8) + bx / 8 : bx;
    unsigned char* ws = a.ws;
    const float *x_p = a.in[0], *x_s = a.in[1], *cache_k = a.in[2], *cache_v = a.in[3], *state_pool = a.in[4], *norm_g = a.in[5], *w_in = a.in[6], *w_pool = a.in[7],
                *pool_scale = a.in[8], *w_br_a = a.in[9], *w_br_b = a.in[10], *w_out = a.in[11], *final_g = a.in[12];
    float* out = a.out;
    float* rowss = (float*)(ws + WS_ROWSS);
    bf16_t *WT_in = (bf16_t*)(ws + WS_WIN), *WT_pool = (bf16_t*)(ws + WS_WPOOL), *WT_bra = (bf16_t*)(ws + WS_WBRA), *WT_brb = (bf16_t*)(ws + WS_WBRB), *WT_out = (bf16_t*)(ws + WS_WOUT);
    bf16_t *Qb = (bf16_t*)(ws + WS_Q), *GAb = (bf16_t*)(ws + WS_GA), *Ub = (bf16_t*)(ws + WS_U), *GBb = (bf16_t*)(ws + WS_GB), *Hb = (bf16_t*)(ws + WS_H), *MGb = (bf16_t*)(ws + WS_MG);
    bf16_t *Pb = Hb, *Mb = Ub;
    LAS unsigned char* ldsl = (LAS unsigned char*)lds;
    const int lo = a.ph_lo, hi_ = a.ph_hi;
    volatile LAS unsigned* MISC = (volatile LAS unsigned*)(ldsl + 131072 + 1024);
    if (tid < 16) MISC[tid] = 0u;
    __syncthreads();
    const XcdBarrier xbar = xcd_barrier_post((unsigned*)(ws + WS_BAR), MISC);
#define IN(k) (lo <= (k) && (k) < hi_)
#define FULLSYNC() do { asm volatile("s_waitcnt vmcnt(0) lgkmcnt(0)" ::: "memory"); grid.sync(); \
        __builtin_amdgcn_fence(__ATOMIC_ACQUIRE, "agent"); asm volatile("s_waitcnt vmcnt(0)" ::: "memory"); __syncthreads(); } while (0)
#define SEAM(k) do { if (IN(k) && IN((k) + 1)) xcd_barrier(xbar); } while (0)

    if (lo < 0) FULLSYNC();

    if (IN(0)) {
        LAS float* scr = (LAS float*)(ldsl + wave * 16384);
        const int gw = vcu * 8 + wave, NGW = G * 8;
        constexpr int I_IN = (D / 64) * (NIN / 32), I_SQ = (D / 64) * (D / 32), I_PL = (256 / 64) * (256 / 32);
        constexpr int NITEMS = I_IN + 3 * I_SQ + 4 * I_PL;
        for (int it = gw; it < NITEMS; it += NGW) {
            int r = it;
            if (r < I_IN) { p0_transpose_item(w_in, D, NIN, WT_in, scr, r, lane); continue; } r -= I_IN;
            if (r < I_SQ) { p0_transpose_item(w_br_a, D, D, WT_bra, scr, r, lane); continue; } r -= I_SQ;
            if (r < I_SQ) { p0_transpose_item(w_br_b, D, D, WT_brb, scr, r, lane); continue; } r -= I_SQ;
            if (r < I_SQ) { p0_transpose_item(w_out, D, D, WT_out, scr, r, lane); continue; } r -= I_SQ;
            const int g = r / I_PL; p0_transpose_item(w_pool + (size_t)g * 65536, 256, 256, WT_pool + (size_t)g * 65536, scr, r % I_PL, lane);
        }
        for (int m0 = gw; m0 < MT; m0 += 2 * NGW) {
            const int m1 = m0 + NGW < MT ? m0 + NGW : m0;
            const float* xr0 = m0 < MP ? x_p + (size_t)m0 * D : x_s + (size_t)(m0 - MP) * D; const float* xr1 = m1 < MP ? x_p + (size_t)m1 * D : x_s + (size_t)(m1 - MP) * D;
            const f32x4* gr = (const f32x4*)norm_g + lane;
            f32x4 v0[4], v1[4]; float s0 = 0.f, s1 = 0.f;
#pragma unroll
            for (int j = 0; j < 4; ++j) { v0[j] = __builtin_nontemporal_load((const f32x4*)xr0 + lane + 64 * j); v1[j] = __builtin_nontemporal_load((const f32x4*)xr1 + lane + 64 * j); }
#pragma unroll
            for (int j = 0; j < 4; ++j) { s0 += (v0[j].x * v0[j].x + v0[j].y * v0[j].y) + (v0[j].z * v0[j].z + v0[j].w * v0[j].w); s1 += (v1[j].x * v1[j].x + v1[j].y * v1[j].y) + (v1[j].z * v1[j].z + v1[j].w * v1[j].w); }
            const float r0 = 1.0f / sqrtf(wave_sum(s0) * (1.f / D) + EPS), r1 = 1.0f / sqrtf(wave_sum(s1) * (1.f / D) + EPS);
            u32x2* o0 = (u32x2*)(Hb + (size_t)m0 * D) + lane; u32x2* o1 = (u32x2*)(Hb + (size_t)m1 * D) + lane;
#pragma unroll
            for (int j = 0; j < 4; ++j) { const f32x4 gv = gr[64 * j]; u32x2 w;
                w.x = cvt_pk_bf16(v0[j].x * r0 * gv.x, v0[j].y * r0 * gv.y); w.y = cvt_pk_bf16(v0[j].z * r0 * gv.z, v0[j].w * r0 * gv.w); o0[64 * j] = w;
                w.x = cvt_pk_bf16(v1[j].x * r1 * gv.x, v1[j].y * r1 * gv.y); w.y = cvt_pk_bf16(v1[j].z * r1 * gv.z, v1[j].w * r1 * gv.w); o1[64 * j] = w; }
        }
        for (int i = bx * 512 + tid; i < MT; i += G * 512) rowss[i] = 0.f;
    }
    SEAM(0);

    if (IN(1)) {
        pg8::Sched S{}; S.nM = MT / 256; S.nN = NIN / 256; S.nwg = S.nM * S.nN; S.G = G; S.c = bx; S.dual = 0;
        S.A0 = S.A1 = (const char*)Hb; S.B0 = S.B1 = (const char*)WT_in; S.a_pm = (size_t)256 * D * 2; S.a_pn = 0; S.b_pn = (size_t)256 * D * 2;
        EpiIn E{Qb, GAb, Ub, GBb, MGb, out};
        pg8::gemm_phase<EpiIn>(ldsl, D, D, D, S, E);
    }
    SEAM(1);

    if (IN(2)) {
        constexpr int NU_S = SB * NH, NU_P = NB * NH * (T / 256), NU = NU_S + NU_P;
        for (int L = vcu; L < NU_S; L += G) {
            att::AttUnit U; const int b = L / NH, h = L % NH; const size_t ro = (size_t)(MP + b * TS) * D + h * HD;
            U.Q = Qb + ro; U.G = GAb + ro;
            U.Kc = cache_k + (size_t)b * PAST * D + h * HD; U.Vc = cache_v + (size_t)b * PAST * D + h * HD;
            U.Kn = out + OFF_KS + (size_t)b * TS * D + h * HD; U.Vn = out + OFF_VS + (size_t)b * TS * D + h * HD;
            U.Kb = U.Vb = nullptr; U.ncache_tiles = PAST / 64; U.qpos0 = PAST; U.nq = TS;
            att::attn_unit_f32(U, (char*)lds);
        }
        { int L0 = vcu; while (L0 < NU_S) L0 += G;
          att::attn_prompt_stream(Qb, GAb, (const bf16_t*)(out + OFF_Y), L0 - NU_S, G, NU_P, (char*)lds); }
        {
            pg8::Sched S3{}; S3.nM = MP / 256; S3.nN = 4; S3.nwg = S3.nM * S3.nN; S3.G = G; S3.c = bx; S3.dual = 0;
            pg8::Unit u;
            for (int i = 0; S3.next(i, u); ++i)
                for (int pass = 0; pass < 2; ++pass) {
                    const int task = pass * 512 + tid, row0 = u.pm * 256 + (task >> 5) * 8, col = u.pn * 256 + (task & 31) * 8;
                    if (u.pn == 0) pool_chunk<2>(Ub, Pb, state_pool, row0, col);
                    else if (u.pn == 1) pool_chunk<4>(Ub, Pb, state_pool, row0, col);
                    else if (u.pn == 2) pool_chunk<8>(Ub, Pb, state_pool, row0, col);
                    else pool_chunk<16>(Ub, Pb, state_pool, row0, col);
                }
            for (int t = vcu; t < 256; t += G)
                if (tid < 128) {
                    const int g = (t & 15) >> 2, row0 = MP + (t >> 4) * 32 + (tid >> 5) * 8, col = g * 256 + (tid & 31) * 8;
                    if (g == 0) pool_chunk<2>(Ub, Pb, state_pool, row0, col);
                    else if (g == 1) pool_chunk<4>(Ub, Pb, state_pool, row0, col);
                    else if (g == 2) pool_chunk<8>(Ub, Pb, state_pool, row0, col);
                    else pool_chunk<16>(Ub, Pb, state_pool, row0, col);
                }
            asm volatile("s_waitcnt vmcnt(0)" ::: "memory");
            __syncthreads();
        }
    }

    if (IN(3)) {
        pg8::Sched S{}; S.nM = MP / 256; S.nN = 4; S.nwg = S.nM * S.nN; S.G = G; S.c = bx; S.dual = 0;
        S.A0 = S.A1 = (const char*)Pb; S.B0 = S.B1 = (const char*)WT_pool; S.a_pm = (size_t)256 * D * 2; S.a_pn = 256 * 2; S.b_pn = (size_t)256 * 256 * 2;
        EpiPool E{GBb, pool_scale};
        pg8::gemm_phase<EpiPool>(ldsl, D, 256, 256, S, E);
        for (int t = vcu; t < 256; t += G) {
            const int r0 = MP + (t >> 4) * 32 + (wave >> 2) * 16, c0 = (t & 15) * 64 + (wave & 3) * 16, g = c0 >> 8, li = lane & 15, lq = lane >> 4;
            const int rt0 = MP + (t >> 4) * 32, ct0 = (t & 15) * 64;
            const f32x4 acc = small_tile_ksplit(Pb + (size_t)rt0 * D + g * 256, D, WT_pool + (size_t)g * 65536 + (size_t)(ct0 - g * 256) * 256, 256, 256, (LAS float*)ldsl, wave, lane);
            const int col = c0 + li; const float sc = pool_scale[col];
#pragma unroll
            for (int j = 0; j < 4; ++j) { bf16_t* p = GBb + (size_t)(r0 + lq * 4 + j) * D + col; *p = f2bf(acc[j] * sc * bf2f(*p)); }
        }
    }
    SEAM(3);

    if (IN(4)) {
        pg8::Sched S{}; S.nM = MP / 256; S.nN = 4; S.nwg = S.nM * S.nN; S.G = G; S.c = bx; S.dual = 1;
        S.A0 = (const char*)Qb; S.A1 = (const char*)GBb; S.B0 = (const char*)WT_bra; S.B1 = (const char*)WT_brb; S.a_pm = (size_t)256 * D * 2; S.a_pn = 0; S.b_pn = (size_t)256 * D * 2;
        EpiBr E{Mb, MGb};
        pg8::gemm_phase<EpiBr>(ldsl, D, D, D, S, E);
        for (int t = vcu; t < 256; t += G) {
            const int r0 = MP + (t >> 4) * 32 + (wave >> 2) * 16, c0 = (t & 15) * 64 + (wave & 3) * 16, li = lane & 15, lq = lane >> 4;
            const int rt0 = MP + (t >> 4) * 32, ct0 = (t & 15) * 64;
            const f32x4 ya = small_tile_ksplit(Qb + (size_t)rt0 * D, D, WT_bra + (size_t)ct0 * D, D, D, (LAS float*)ldsl, wave, lane);
            const f32x4 yb = small_tile_ksplit(GBb + (size_t)rt0 * D, D, WT_brb + (size_t)ct0 * D, D, D, (LAS float*)ldsl, wave, lane);
            const int col = c0 + li;
#pragma unroll
            for (int j = 0; j < 4; ++j) { const size_t row = (size_t)(r0 + lq * 4 + j);
                Mb[row * D + col] = f2bf(bf2f(MGb[row * 2 * D + col]) * ya[j] + bf2f(MGb[row * 2 * D + D + col]) * yb[j]); }
        }
    }
    SEAM(4);

    if (IN(5)) {
        pg8::Sched S{}; S.nM = MP / 256; S.nN = 4; S.nwg = S.nM * S.nN; S.G = G; S.c = bx; S.dual = 0;
        S.A0 = S.A1 = (const char*)Mb; S.B0 = S.B1 = (const char*)WT_out; S.a_pm = (size_t)256 * D * 2; S.a_pn = 0; S.b_pn = (size_t)256 * D * 2;
        EpiOut E{x_p, out + OFF_Y, rowss, (unsigned*)(ws + WS_CNT), final_g};
        pg8::gemm_phase<EpiOut>(ldsl, D, D, D, S, E);
        for (int t = vcu; t < 256; t += G) {
            const int r0 = MP + (t >> 4) * 32 + (wave >> 2) * 16, c0 = (t & 15) * 64 + (wave & 3) * 16, li = lane & 15, lq = lane >> 4;
            const int rt0 = MP + (t >> 4) * 32, ct0 = (t & 15) * 64;
            const f32x4 acc = small_tile_ksplit(Mb + (size_t)rt0 * D, D, WT_out + (size_t)ct0 * D, D, D, (LAS float*)ldsl, wave, lane);
            const int col = c0 + li;
#pragma unroll
            for (int j = 0; j < 4; ++j) { const size_t row = (size_t)(r0 + lq * 4 + j);
                const float v = x_s[(row - MP) * D + col] + acc[j]; Qb[row * D + col] = f2bf(v);
                float ss = v * v; ss += __shfl_xor(ss, 1); ss += __shfl_xor(ss, 2); ss += __shfl_xor(ss, 4); ss += __shfl_xor(ss, 8);
                if (li == 0) atomicAdd(rowss + row, ss); }
        }
    }
    SEAM(5);

    if (IN(6)) {
        const int gw = vcu * 8 + wave, NGW = G * 8;
        for (int m0 = MP + gw; m0 < MT; m0 += 2 * NGW) {
            const int m1 = m0 + NGW < MT ? m0 + NGW : m0;
            const u32x2* xr0 = (const u32x2*)(Qb + (size_t)m0 * D) + lane; const u32x2* xr1 = (const u32x2*)(Qb + (size_t)m1 * D) + lane;
            f32x4* yr0 = (f32x4*)(out + OFF_Y + (size_t)m0 * D) + lane; f32x4* yr1 = (f32x4*)(out + OFF_Y + (size_t)m1 * D) + lane; const f32x4* gr = (const f32x4*)final_g + lane;
            u32x2 w0[4], w1[4];
#pragma unroll
            for (int j = 0; j < 4; ++j) { w0[j] = xr0[64 * j]; w1[j] = xr1[64 * j]; }
            const float r0 = 1.0f / sqrtf(__hip_atomic_load(rowss + m0, __ATOMIC_RELAXED, __HIP_MEMORY_SCOPE_AGENT) * (1.f / D) + EPS);
            const float r1 = 1.0f / sqrtf(__hip_atomic_load(rowss + m1, __ATOMIC_RELAXED, __HIP_MEMORY_SCOPE_AGENT) * (1.f / D) + EPS);
#pragma unroll
            for (int j = 0; j < 4; ++j) { const f32x4 gv = gr[64 * j];
                const f32x4 a = {bf_lo(w0[j].x), bf_hi(w0[j].x), bf_lo(w0[j].y), bf_hi(w0[j].y)}, b = {bf_lo(w1[j].x), bf_hi(w1[j].x), bf_lo(w1[j].y), bf_hi(w1[j].y)};
                yr0[64 * j] = a * r0 * gv; yr1[64 * j] = b * r1 * gv; }
        }
    }
#undef IN
#undef SEAM
}

extern "C" void kernel_launch(void* const* d_in, const int* in_sizes, int n_in, void* d_out, int out_size, void* d_ws, size_t ws_size, hipStream_t stream) {
    static int grid = 0;
    if (grid == 0) {
        if (n_in != 13 || in_sizes[0] != MP * D || (size_t)out_size != OFF_PS + (size_t)SB * PBUF * D || ws_size < WS_END) {
            fprintf(stderr, "kernel_launch: unexpected shapes: n_in %d in0 %d out %d ws %zu (need %zu)\n", n_in, n_in > 0 ? in_sizes[0] : -1, out_size, ws_size, (size_t)WS_END); grid = -1; return; }
        int dev = 0, cus = 0, per_cu = 0;
        if (hipGetDevice(&dev) != hipSuccess || hipDeviceGetAttribute(&cus, hipDeviceAttributeMultiprocessorCount, dev) != hipSuccess) { grid = -1; return; }
        if (hipFuncSetAttribute((const void*)fwd_kernel, hipFuncAttributeMaxDynamicSharedMemorySize, LDS_BYTES) != hipSuccess) { fprintf(stderr, "kernel_launch: hipFuncSetAttribute failed\n"); grid = -1; return; }
        if (hipOccupancyMaxActiveBlocksPerMultiprocessor(&per_cu, (const void*)fwd_kernel, 512, LDS_BYTES) != hipSuccess || per_cu < 1) { fprintf(stderr, "kernel_launch: occupancy query failed (%d)\n", per_cu); grid = -1; return; }
        grid = cus * per_cu;
    }
    if (grid < 0) return;
    if (hipMemsetAsync((char*)d_ws + WS_BAR, 0, WS_BAR_BYTES, stream) != hipSuccess) { fprintf(stderr, "kernel_launch: memset failed\n"); return; }
    Args a{};
    for (int i = 0; i < 13; ++i) a.in[i] = (const float*)d_in[i];
    a.out = (float*)d_out; a.ws = (unsigned char*)d_ws; a.ph_lo = 0; a.ph_hi = 7;
    void* args[] = {&a};
    const hipError_t e = hipLaunchCooperativeKernel((const void*)fwd_kernel, dim3(grid), dim3(512), args, LDS_BYTES, stream);
    if (e != hipSuccess) fprintf(stderr, "kernel_launch: cooperative launch failed: %s (grid %d)\n", hipGetErrorString(e), grid);
}
```
